# Optimizing an MI355X kernel written in HIP

```python
import jax, jax.numpy as jnp
from jax import lax
import numpy as np

D_MODEL = 2048
BATCH = 2
SEQ = 16384
DEPTH = 1
DEC_BATCH = 32
DEC_SEQ = 64
PAST_LEN = 1024

CHUNK = 64
N_META = 16
MIX_WIDTH = D_MODEL
HG_WIDTH = MIX_WIDTH // 2
HG_HEAD_DIM = 128
HG_HEADS = HG_WIDTH // HG_HEAD_DIM
RW_WIDTH = MIX_WIDTH - HG_WIDTH
RW_HEAD_DIM = 64
RW_HEADS = RW_WIDTH // RW_HEAD_DIM
RW_LORA = 64
HG_PROJ = 4 * HG_WIDTH
RW_SHIFT_WIDTH = 4 * RW_WIDTH + 2 * RW_LORA
P_TOTAL = HG_PROJ + RW_SHIFT_WIDTH
NORM_EPS = 1e-6
RW_GN_EPS = 64e-5
KK_EPS = 1e-12

kernel_name = "hymba_hgrn2_rwkv7_streaming_step"


def _rmsnorm(x, g):
    xf = x.astype(jnp.float32)
    y = xf * lax.rsqrt(jnp.mean(xf * xf, axis=-1, keepdims=True) + NORM_EPS)
    return (y * g.astype(jnp.float32)).astype(x.dtype)


def _hgrn2_chunk(S, xs):
    q, k, v, g = xs
    G = jnp.cumsum(g, axis=2)
    causal = jnp.tril(jnp.ones((CHUNK, CHUNK), dtype=bool))
    diff = G[:, :, :, None, :] - G[:, :, None, :, :]
    decay = jnp.exp(jnp.where(causal[None, None, :, :, None], diff, -jnp.inf))
    scores = jnp.einsum('bhid,bhjd,bhijd->bhij', q, k, decay)
    o = (jnp.einsum('bhij,bhjv->bhiv', scores, v)
         + jnp.einsum('bhid,bhdv->bhiv', q * jnp.exp(G), S))
    G_last = G[:, :, -1:, :]
    S_new = (jnp.exp(G_last[:, :, 0, :])[..., None] * S
             + jnp.einsum('bhjd,bhjv->bhdv', k * jnp.exp(G_last - G), v))
    return S_new, o


def _hgrn2_mixer(p, lb, norm_g, S0):
    B, T, _ = p.shape
    q, f, i, gate = jnp.split(p, 4, axis=-1)
    q = jax.nn.silu(q.astype(jnp.float32))
    forget = lb + (1.0 - lb) * jax.nn.sigmoid(f.astype(jnp.float32))
    log_f = jnp.log(forget)
    k = 1.0 - forget
    v = i.astype(jnp.float32)
    n_chunks = -(-T // CHUNK)
    pad = n_chunks * CHUNK - T

    def to_chunks(t):
        t = jnp.pad(t, ((0, 0), (0, pad), (0, 0)))
        t = t.reshape(B, n_chunks, CHUNK, HG_HEADS, HG_HEAD_DIM)
        return t.transpose(1, 0, 3, 2, 4)

    S_final, o = lax.scan(_hgrn2_chunk, S0.astype(jnp.float32),
                          (to_chunks(q), to_chunks(k), to_chunks(v), to_chunks(log_f)))
    o = o.transpose(1, 0, 3, 2, 4).reshape(B, n_chunks * CHUNK, HG_HEADS, HG_HEAD_DIM)[:, :T]
    o = o * lax.rsqrt(jnp.mean(o * o, axis=-1, keepdims=True) + NORM_EPS)
    o = o * norm_g.astype(jnp.float32).reshape(HG_HEADS, HG_HEAD_DIM)
    o = o.reshape(B, T, HG_WIDTH) * jax.nn.silu(gate.astype(jnp.float32))
    return o.astype(p.dtype), S_final


def _rwkv7_step(S, inp):
    r_t, w_t, k_t, v_t, kk_t, b_t = inp
    sa = jnp.einsum('bhvk,bhk->bhv', S, -kk_t)
    S = (S * w_t[:, :, None, :] + sa[..., None] * b_t[:, :, None, :]
         + v_t[..., None] * k_t[:, :, None, :])
    return S, jnp.einsum('bhvk,bhk->bhv', S, r_t)


def _rwkv7_mixer(p, shift_prev, mu, w0, w2, a0, a2, k_k, k_a, r_k, ln_w, ln_b, S0):
    B, T, _ = p.shape
    prev = jnp.concatenate([shift_prev.astype(p.dtype), p[:, :-1]], axis=1)
    xm = (p + (prev - p) * mu).astype(jnp.float32)
    r = xm[..., :RW_WIDTH]
    k = xm[..., RW_WIDTH:2 * RW_WIDTH]
    v = xm[..., 2 * RW_WIDTH:3 * RW_WIDTH]
    gate = xm[..., 3 * RW_WIDTH:4 * RW_WIDTH]
    wd = xm[..., 4 * RW_WIDTH:4 * RW_WIDTH + RW_LORA]
    ad = xm[..., 4 * RW_WIDTH + RW_LORA:]
    w = w0.astype(jnp.float32) + jnp.tanh(wd) @ w2.astype(jnp.float32)
    decay = jnp.exp(-jnp.exp(-jax.nn.softplus(-w) - 0.5))
    a = jax.nn.sigmoid(a0.astype(jnp.float32) + ad @ a2.astype(jnp.float32))
    heads = lambda t: t.reshape(B, T, RW_HEADS, RW_HEAD_DIM)
    kk = heads(k * k_k.astype(jnp.float32))
    kk = kk / jnp.maximum(jnp.sqrt(jnp.sum(kk * kk, axis=-1, keepdims=True)), KK_EPS)
    k = k * (1.0 + (a - 1.0) * k_a.astype(jnp.float32))
    r, k, v, decay, a = heads(r), heads(k), heads(v), heads(decay), heads(a)
    b = kk * a
    tm = lambda t: t.transpose(1, 0, 2, 3)
    S_final, y = lax.scan(_rwkv7_step, S0.astype(jnp.float32),
                          (tm(r), tm(decay), tm(k), tm(v), tm(kk), tm(b)))
    y = tm(y)
    mean = jnp.mean(y, axis=-1, keepdims=True)
    var = jnp.mean(jnp.square(y - mean), axis=-1, keepdims=True)
    y = ((y - mean) * lax.rsqrt(var + RW_GN_EPS) * ln_w.astype(jnp.float32).reshape(RW_HEADS, RW_HEAD_DIM)
         + ln_b.astype(jnp.float32).reshape(RW_HEADS, RW_HEAD_DIM))
    y = y + jnp.sum(r * k * r_k.astype(jnp.float32), axis=-1, keepdims=True) * v
    out = y.reshape(B, T, RW_WIDTH) * jax.nn.silu(gate)
    return out.astype(p.dtype), S_final, p[:, -1:]


def _trunk(h, hg_S, rw_S, shift, norm_pre, w_in, hg_lower_bounds, hg_norm, rw_mu, rw_w0, rw_w2,
           rw_a0, rw_a2, rw_k_k, rw_k_a, rw_r_k, rw_ln_w, rw_ln_b, w_out, norm_post):
    lbs = jnp.cumsum(jax.nn.softmax(hg_lower_bounds.astype(jnp.float32), axis=0), axis=0)
    new_hg, new_rw, new_shift = [], [], []
    for l in range(DEPTH):
        u = _rmsnorm(h, norm_pre[l])
        proj = u @ w_in[l]
        hg_out, hg_new = _hgrn2_mixer(proj[..., :HG_PROJ], lbs[l], hg_norm[l], hg_S[l])
        rw_out, rw_new, sh_new = _rwkv7_mixer(proj[..., HG_PROJ:], shift[l], rw_mu[l], rw_w0[l], rw_w2[l],
                                              rw_a0[l], rw_a2[l], rw_k_k[l], rw_k_a[l], rw_r_k[l],
                                              rw_ln_w[l], rw_ln_b[l], rw_S[l])
        mixed = jnp.concatenate([hg_out, rw_out], axis=-1)
        h = h + _rmsnorm(mixed @ w_out[l], norm_post[l])
        new_hg.append(hg_new)
        new_rw.append(rw_new)
        new_shift.append(sh_new)
    return h, jnp.stack(new_hg), jnp.stack(new_rw), jnp.stack(new_shift)


def setup_inputs(seed: int = 0) -> dict:
    key = jax.random.key(seed)
    ks = jax.random.split(key, 24)
    f32 = jnp.float32
    nrm = lambda k, shape, s: s * jax.random.normal(k, shape, f32)
    return {
        "x_prompt": nrm(ks[0], (BATCH, SEQ, D_MODEL), 1.0),
        "x_sample": nrm(ks[1], (DEC_BATCH, DEC_SEQ, D_MODEL), 1.0),
        "state_hgrn": nrm(ks[2], (DEPTH, DEC_BATCH, HG_HEADS, HG_HEAD_DIM, HG_HEAD_DIM), 0.5),
        "state_rwkv": nrm(ks[3], (DEPTH, DEC_BATCH, RW_HEADS, RW_HEAD_DIM, RW_HEAD_DIM), 1.0),
        "state_shift": nrm(ks[4], (DEPTH, DEC_BATCH, 1, RW_SHIFT_WIDTH), 1.0),
        "meta_tokens": nrm(ks[5], (N_META, D_MODEL), 1.0),
        "norm_pre": 1.0 + nrm(ks[6], (DEPTH, D_MODEL), 0.02),
        "w_in": nrm(ks[7], (DEPTH, D_MODEL, P_TOTAL), D_MODEL ** -0.5),
        "hg_lower_bounds": nrm(ks[8], (DEPTH + 1, HG_WIDTH), 1.0),
        "hg_norm": 1.0 + nrm(ks[9], (DEPTH, HG_WIDTH), 0.02),
        "rw_mu": jax.random.uniform(ks[10], (DEPTH, RW_SHIFT_WIDTH), f32),
        "rw_w0": jax.random.uniform(ks[11], (DEPTH, RW_WIDTH), f32, -6.0, -1.0),
        "rw_w2": nrm(ks[12], (DEPTH, RW_LORA, RW_WIDTH), 0.5 * RW_LORA ** -0.5),
        "rw_a0": nrm(ks[13], (DEPTH, RW_WIDTH), 0.5),
        "rw_a2": nrm(ks[14], (DEPTH, RW_LORA, RW_WIDTH), 0.5 * RW_LORA ** -0.5),
        "rw_k_k": 0.85 + nrm(ks[15], (DEPTH, RW_WIDTH), 0.02),
        "rw_k_a": 1.0 + nrm(ks[16], (DEPTH, RW_WIDTH), 0.02),
        "rw_r_k": nrm(ks[17], (DEPTH, RW_HEADS, RW_HEAD_DIM), 0.1),
        "rw_ln_w": 1.0 + nrm(ks[18], (DEPTH, RW_WIDTH), 0.02),
        "rw_ln_b": nrm(ks[19], (DEPTH, RW_WIDTH), 0.02),
        "w_out": nrm(ks[20], (DEPTH, MIX_WIDTH, D_MODEL), MIX_WIDTH ** -0.5),
        "norm_post": 1.0 + nrm(ks[21], (DEPTH, D_MODEL), 0.02),
    }


def reference(x_prompt, x_sample, state_hgrn, state_rwkv, state_shift, meta_tokens, norm_pre, w_in,
              hg_lower_bounds, hg_norm, rw_mu, rw_w0, rw_w2, rw_a0, rw_a2, rw_k_k, rw_k_a, rw_r_k,
              rw_ln_w, rw_ln_b, w_out, norm_post):
    weights = (norm_pre, w_in, hg_lower_bounds, hg_norm, rw_mu, rw_w0, rw_w2, rw_a0, rw_a2,
               rw_k_k, rw_k_a, rw_r_k, rw_ln_w, rw_ln_b, w_out, norm_post)
    B = x_prompt.shape[0]
    meta = jnp.broadcast_to(meta_tokens[None].astype(x_prompt.dtype), (B, N_META, D_MODEL))
    h0 = jnp.concatenate([meta, x_prompt], axis=1)
    hg0 = jnp.zeros((DEPTH, B, HG_HEADS, HG_HEAD_DIM, HG_HEAD_DIM), jnp.float32)
    rw0 = jnp.zeros((DEPTH, B, RW_HEADS, RW_HEAD_DIM, RW_HEAD_DIM), jnp.float32)
    sh0 = jnp.zeros((DEPTH, B, 1, RW_SHIFT_WIDTH), x_prompt.dtype)
    hp, hg_p, rw_p, sh_p = _trunk(h0, hg0, rw0, sh0, *weights)
    y_prompt = hp[:, N_META:]
    y_sample, hg_s, rw_s, sh_s = _trunk(x_sample, state_hgrn, state_rwkv, state_shift, *weights)
    return (y_prompt, y_sample, hg_p, rw_p, sh_p, hg_s, rw_s, sh_s)
```

```cpp
#include <hip/hip_runtime.h>
#include <hip/hip_cooperative_groups.h>
#include <cstdio>
namespace cg = cooperative_groups;

typedef __attribute__((ext_vector_type(8))) short bf16x8_t;
typedef __attribute__((ext_vector_type(4))) float f32x4;
typedef __attribute__((ext_vector_type(2))) float f32x2;
typedef __attribute__((ext_vector_type(2))) __bf16 bf16x2_t;
typedef unsigned short u16;
typedef unsigned int u32;

constexpr int D = 2048, NB = 2, SEQ = 16384, NMETA = 16, TP = SEQ + NMETA;
constexpr int DB = 32, DS = 64;
constexpr int MP = NB * TP;
constexpr int MS = DB * DS;
constexpr int M = MP + MS;
constexpr int MPAD = 35072;
constexpr int PT = 8320, HGP = 4096, RWP = 4224;
constexpr int LDU = 2112, LDH = 4160, LDP = 1088;
constexpr long OUT1 = 67108864L, OUT2 = 71303168L, OUT3 = 71565312L, OUT4 = 71696384L,
               OUT5 = 71704832L, OUT6 = 75899136L, OUT7 = 77996288L;
constexpr int SMEM_BYTES = 131072;

struct Params {
  const float *x_prompt, *x_sample, *state_hgrn, *state_rwkv, *state_shift, *meta, *norm_pre, *w_in,
      *hlb, *hg_norm, *mu, *w0, *w2, *a0, *a2, *k_k, *k_a, *r_k, *ln_w, *ln_b, *w_out, *norm_post;
  float* out;
  u16 *WinT, *WoutT, *U, *RA, *pl_r, *pl_k, *pl_v, *pl_kk, *pl_b, *pl_e, *pl_g;
  float *bonus, *sumsq;
  int* queue;
  u16 *w2T, *a2T;
  float* Gp;
  float* omlb;
};

__device__ __forceinline__ u32 pack2(float a, float b) {
  f32x2 v = {a, b};
  bf16x2_t r = __builtin_convertvector(v, bf16x2_t);
  return __builtin_bit_cast(u32, r);
}
__device__ __forceinline__ u16 f2bf(float a) { return (u16)(pack2(a, 0.f) & 0xffffu); }
__device__ __forceinline__ float bf2f(u16 v) { return __uint_as_float(((u32)v) << 16); }
__device__ __forceinline__ float bflo(u32 v) { return __uint_as_float(v << 16); }
__device__ __forceinline__ float bfhi(u32 v) { return __uint_as_float(v & 0xffff0000u); }
__device__ __forceinline__ float frcp(float x) { return __builtin_amdgcn_rcpf(x); }
__device__ __forceinline__ float sigmoidf_(float x) { return frcp(1.0f + __expf(-x)); }
__device__ __forceinline__ float tanhf_(float x) { return 1.0f - 2.0f * frcp(__expf(2.0f * x) + 1.0f); }
template <int CTRL>
__device__ __forceinline__ float dpp_add(float x) {
  int v = __builtin_amdgcn_update_dpp(0, __float_as_int(x), CTRL, 0xF, 0xF, true);
  return x + __int_as_float(v);
}
__device__ __forceinline__ float allreduce16(float x) {
  x = dpp_add<0xB1>(x);
  x = dpp_add<0x4E>(x);
  x = dpp_add<0x141>(x);
  x = dpp_add<0x140>(x);
  return x;
}
__device__ __forceinline__ float allreduce4(float x) {
  x = dpp_add<0xB1>(x);
  x = dpp_add<0x4E>(x);
  return x;
}
__device__ __forceinline__ float allreduce64(float x) {
  x = allreduce16(x);
  x += __shfl_xor(x, 16);
  x += __shfl_xor(x, 32);
  return x;
}
__device__ __forceinline__ void unpack8_store(uint4 u, float* d) {
  float4 a, b;
  a.x = bflo(u.x); a.y = bfhi(u.x); a.z = bflo(u.y); a.w = bfhi(u.y);
  b.x = bflo(u.z); b.y = bfhi(u.z); b.z = bflo(u.w); b.w = bfhi(u.w);
  *(float4*)d = a;
  *(float4*)(d + 4) = b;
}
__device__ __forceinline__ const float* row_src(const Params& p, int row) {
  if (row < MP) {
    int b = row / TP, t = row - b * TP;
    if (t < NMETA) return p.meta + (long)t * D;
    return p.x_prompt + ((long)b * SEQ + (t - NMETA)) * D;
  }
  return p.x_sample + (long)(row - MP) * D;
}

__device__ void phase_prep(const Params& p, char* smem) {
  float* tile = (float*)smem;
  const int tid = threadIdx.x, wave = tid >> 6, lane = tid & 63;
  const int ntile_in = 32 * 130, ntile_out = 32 * 32;
  for (int t = blockIdx.x; t < ntile_in + ntile_out; t += gridDim.x) {
    const float* W; u16* WT; int N, tk, tn;
    if (t < ntile_in) { W = p.w_in; WT = p.WinT; N = PT; tk = t / 130; tn = t - tk * 130; }
    else { int tt = t - ntile_in; W = p.w_out; WT = p.WoutT; N = D; tk = tt >> 5; tn = tt & 31; }
#pragma unroll
    for (int i = 0; i < 8; ++i) {
      int k = (tid >> 6) + 8 * i;
      tile[k * 65 + (tid & 63)] = W[(long)(tk * 64 + k) * N + tn * 64 + (tid & 63)];
    }
    __syncthreads();
    {
      int n = tid >> 3, kc = (tid & 7) * 8;
      float v[8];
#pragma unroll
      for (int j = 0; j < 8; ++j) v[j] = tile[(kc + j) * 65 + n];
      uint4 o;
      o.x = pack2(v[0], v[1]); o.y = pack2(v[2], v[3]); o.z = pack2(v[4], v[5]); o.w = pack2(v[6], v[7]);
      *(uint4*)(WT + (long)(tn * 64 + n) * LDU + tk * 64 + kc) = o;
    }
    __syncthreads();
  }
  for (int row = blockIdx.x * 8 + wave; row < MPAD; row += gridDim.x * 8) {
    u16* dst = p.U + (long)row * LDU;
    if (row >= M) {
      uint2 z = {0u, 0u};
#pragma unroll
      for (int i = 0; i < 8; ++i) ((uint2*)dst)[lane + 64 * i] = z;
      continue;
    }
    const float4* src = (const float4*)row_src(p, row);
    float4 v[8];
    float ss = 0.f;
#pragma unroll
    for (int i = 0; i < 8; ++i) {
      v[i] = src[lane + 64 * i];
      ss += v[i].x * v[i].x + v[i].y * v[i].y + v[i].z * v[i].z + v[i].w * v[i].w;
    }
    ss = allreduce64(ss);
    float rstd = rsqrtf(ss * (1.0f / D) + 1e-6f);
#pragma unroll
    for (int i = 0; i < 8; ++i) {
      float4 g = ((const float4*)p.norm_pre)[lane + 64 * i];
      uint2 o;
      o.x = pack2(v[i].x * rstd * g.x, v[i].y * rstd * g.y);
      o.y = pack2(v[i].z * rstd * g.z, v[i].w * rstd * g.w);
      ((uint2*)dst)[lane + 64 * i] = o;
    }
  }
  for (int i = blockIdx.x * blockDim.x + tid; i < M; i += gridDim.x * blockDim.x) p.sumsq[i] = 0.f;
  if (blockIdx.x == 0 && tid == 0) { p.queue[0] = 0; p.queue[16] = 0; }
  if (blockIdx.x == 1) for (int i = tid; i < 1024; i += blockDim.x) p.omlb[i] = 1.0f - sigmoidf_(p.hlb[i] - p.hlb[1024 + i]);
  for (int i = blockIdx.x * blockDim.x + tid; i < 65536; i += gridDim.x * blockDim.x) {
    int n = i >> 6, k = i & 63;
    p.w2T[i] = f2bf(p.w2[k * 1024 + n]);
    p.a2T[i] = f2bf(p.a2[k * 1024 + n]);
  }
}

namespace pg8 {
#define PG8_LAS __attribute__((address_space(3)))
constexpr int BM = 256, BK = 64, HALF = 128, HTB = HALF * BK * 2, STAGE_BYTES = 8 * HTB, NXCD = 8, WGM = 8;
__device__ __forceinline__ int lds_byte(int r, int c) { const int st = (r >> 4) * 2 + (c >> 5), rr = r & 15, cc = c & 31, ob = rr * 64 + cc * 2; return st * 1024 + (ob ^ (((ob >> 9) & 1) << 5)); }
__device__ __forceinline__ void stage_rc(int b, int& R, int& C) { const int st = b / 1024, sb = b % 1024, swz = sb ^ (((sb >> 9) & 1) << 5); R = (st >> 1) * 16 + swz / 64; C = (st & 1) * 32 + (swz % 64) / 2; }
struct Unit { int pm, pn; };
struct Gemm { const u16* A; const u16* Bt; int M, N, K, ld; };
struct StaticOrder {
  int nM, nN, nwg, G, c;
  __device__ void init(int M_, int N_, int G_, int c_) { nM = M_ / BM; nN = N_ / BM; nwg = nM * nN; G = G_; c = c_; }
  __device__ bool next(int i, Unit& u) const {
    const long L = (long)i * G + c; if (L >= nwg) return false;
    int wgid = (int)L; { const int q = nwg / NXCD, r = nwg % NXCD, xcd = wgid % NXCD, off = wgid / NXCD; wgid = (xcd < r ? xcd * (q + 1) : r * (q + 1) + (xcd - r) * q) + off; }
    const int nig = WGM * nN, gid = wgid / nig, fm = gid * WGM, gsz = (nM - fm) < WGM ? (nM - fm) : WGM;
    u.pm = fm + ((wgid % nig) % gsz); u.pn = (wgid % nig) / gsz; return true;
  }
};

template <class Epi>
__device__ __forceinline__ void gemm_phase(PG8_LAS unsigned char* lds, const Gemm g, const StaticOrder& S, const Epi& E) {
  const int tid = threadIdx.x, wid = __builtin_amdgcn_readfirstlane(tid >> 6), lane = tid & 63, wr = wid >> 2, wc = wid & 3, fr = lane & 15, fq = lane >> 4;
  const int K = g.K, nt = K / BK, ld = g.ld;
  unsigned voffA[2], voffB[2];
#pragma unroll
  for (int i = 0; i < 2; ++i) { int R, C; stage_rc(tid * 16 + i * 8192, R, C); voffA[i] = (unsigned)(R * ld + C) * 2u; voffB[i] = voffA[i]; }
  const size_t kstep = (size_t)(BK * 2);
  const size_t hstep = (size_t)HALF * ld * 2;
  const size_t tstep = 2 * hstep;
  const unsigned ldsw = (unsigned)wid * 1024u;
  const int aoff = lds_byte(wr * 64 + fr, fq * 8), boff = lds_byte(wc * 32 + fr, fq * 8);
#define PG8_SA(b, h) (((b) * 2 + (h)) * HTB)
#define PG8_SB(b, h) ((4 + (b) * 2 + (h)) * HTB)
#define PG8_STAGE(bufoff, gbase, voff) do { _Pragma("unroll") for (int _i = 0; _i < 2; ++_i) \
    __builtin_amdgcn_global_load_lds((const unsigned*)((const char*)(gbase) + (voff)[_i]), (PG8_LAS unsigned*)(lds + (bufoff) + ldsw + _i * 8192), 16, 0, 0); } while (0)
#define PG8_LDA(dst, b, h) do { _Pragma("unroll") for (int m = 0; m < 4; ++m) _Pragma("unroll") for (int k = 0; k < 2; ++k) dst[m][k] = *(const PG8_LAS bf16x8_t*)(lds + PG8_SA(b, h) + aoff + m * 2048 + k * 1024); } while (0)
#define PG8_LDB(dst, b, h) do { _Pragma("unroll") for (int n = 0; n < 2; ++n) _Pragma("unroll") for (int k = 0; k < 2; ++k) dst[n][k] = *(const PG8_LAS bf16x8_t*)(lds + PG8_SB(b, h) + boff + n * 2048 + k * 1024); } while (0)
#define PG8_MMA(ai, bj, At, Bt) do { __builtin_amdgcn_s_setprio(1); _Pragma("unroll") for (int m = 0; m < 4; ++m) _Pragma("unroll") for (int n = 0; n < 2; ++n) _Pragma("unroll") for (int k = 0; k < 2; ++k) \
    acc[ai][bj][m][n] = __builtin_amdgcn_mfma_f32_16x16x32_bf16(Bt[n][k], At[m][k], acc[ai][bj][m][n], 0, 0, 0); __builtin_amdgcn_s_setprio(0); } while (0)
#define PG8_WAIT_V(n) asm volatile("s_waitcnt vmcnt(" #n ")" ::: "memory")
#define PG8_WAIT_L(n) asm volatile("s_waitcnt lgkmcnt(" #n ")" ::: "memory")
#define PG8_BAR __builtin_amdgcn_s_barrier()
#define PG8_SCHED __builtin_amdgcn_sched_barrier(0)
  Unit cur, nxt; int ui = 0;
  if (!S.next(0, cur)) return;
  f32x4 acc[2][2][4][2];
#pragma unroll
  for (int a = 0; a < 2; ++a)
#pragma unroll
    for (int b = 0; b < 2; ++b)
#pragma unroll
      for (int m = 0; m < 4; ++m)
#pragma unroll
        for (int n = 0; n < 2; ++n) acc[a][b][m][n] = (f32x4){0.f, 0.f, 0.f, 0.f};
  bf16x8_t At[4][2], B0[2][2], B1[2][2];
  const char* cA = (const char*)g.A + (size_t)cur.pm * tstep; const char* cB = (const char*)g.Bt + (size_t)cur.pn * tstep;
  PG8_STAGE(PG8_SB(0, 0), cB, voffB); PG8_STAGE(PG8_SA(0, 0), cA, voffA); PG8_STAGE(PG8_SB(0, 1), cB + hstep, voffB); PG8_STAGE(PG8_SA(0, 1), cA + hstep, voffA);
  if (wr == 1) PG8_BAR;
  PG8_WAIT_V(4); PG8_BAR;
  PG8_STAGE(PG8_SB(1, 0), cB + kstep, voffB); PG8_STAGE(PG8_SA(1, 0), cA + kstep, voffA); PG8_STAGE(PG8_SB(1, 1), cB + hstep + kstep, voffB);
  PG8_WAIT_V(6); PG8_BAR;
  for (;;) {
    const bool has_next = S.next(ui + 1, nxt);
    const char* nA = has_next ? (const char*)g.A + (size_t)nxt.pm * tstep : cA; const char* nB = has_next ? (const char*)g.Bt + (size_t)nxt.pn * tstep : cB;
    for (int t = 0; t < nt; t += 2) {
      const bool last = (t == nt - 2);
      const char* a1 = cA + (size_t)(t + 1) * kstep;
      const char* a2 = last ? nA : cA + (size_t)(t + 2) * kstep; const char* b2 = last ? nB : cB + (size_t)(t + 2) * kstep;
      const char* a3 = a2 + kstep; const char* b3 = b2 + kstep;
      PG8_LDB(B0, 0, 0); PG8_SCHED; PG8_LDA(At, 0, 0); PG8_STAGE(PG8_SA(1, 1), a1 + hstep, voffA);
      PG8_WAIT_L(8); PG8_BAR; PG8_WAIT_L(0); PG8_MMA(0, 0, At, B0); PG8_BAR; PG8_SCHED;
      PG8_LDB(B1, 0, 1); PG8_STAGE(PG8_SB(0, 0), b2, voffB);
      PG8_BAR; PG8_WAIT_L(0); PG8_MMA(0, 1, At, B1); PG8_BAR;
      PG8_LDA(At, 0, 1); PG8_STAGE(PG8_SA(0, 0), a2, voffA);
      PG8_BAR; PG8_WAIT_L(0); PG8_MMA(1, 0, At, B0); PG8_BAR; PG8_SCHED;
      PG8_STAGE(PG8_SB(0, 1), b2 + hstep, voffB);
      PG8_WAIT_V(6); PG8_BAR; PG8_MMA(1, 1, At, B1); PG8_BAR;
      PG8_LDB(B0, 1, 0); PG8_SCHED; PG8_LDA(At, 1, 0); PG8_STAGE(PG8_SA(0, 1), a2 + hstep, voffA);
      PG8_WAIT_L(8); PG8_BAR; PG8_WAIT_L(0); PG8_MMA(0, 0, At, B0); PG8_BAR; PG8_SCHED;
      PG8_LDB(B1, 1, 1); PG8_STAGE(PG8_SB(1, 0), b3, voffB);
      PG8_BAR; PG8_WAIT_L(0); PG8_MMA(0, 1, At, B1); PG8_BAR;
      PG8_LDA(At, 1, 1); PG8_STAGE(PG8_SA(1, 0), a3, voffA);
      PG8_BAR; PG8_WAIT_L(0); PG8_MMA(1, 0, At, B0); PG8_BAR; PG8_SCHED;
      PG8_STAGE(PG8_SB(1, 1), b3 + hstep, voffB);
      PG8_WAIT_V(6); PG8_BAR; PG8_MMA(1, 1, At, B1); PG8_BAR;
    }
    E(acc, cur, wr, wc, fr, fq);
    if (!has_next) break;
#pragma unroll
    for (int a = 0; a < 2; ++a)
#pragma unroll
      for (int b = 0; b < 2; ++b)
#pragma unroll
        for (int m = 0; m < 4; ++m)
#pragma unroll
          for (int n = 0; n < 2; ++n) acc[a][b][m][n] = (f32x4){0.f, 0.f, 0.f, 0.f};
    cur = nxt; cA = nA; cB = nB; ++ui;
  }
  PG8_WAIT_V(0);
  if (wr == 0) PG8_BAR;
  PG8_BAR;
#undef PG8_SA
#undef PG8_SB
#undef PG8_STAGE
#undef PG8_LDA
#undef PG8_LDB
#undef PG8_MMA
#undef PG8_WAIT_V
#undef PG8_WAIT_L
#undef PG8_BAR
#undef PG8_SCHED
}
}

enum { EPI_RW = 0, EPI_HG = 1, EPI_OUT = 2 };
constexpr int RW_COL0 = HGP - 128;
template <int EPI>
struct Epi {
  u16* RA; float* out; const float* hlb; float* sumsq;
  __device__ __forceinline__ void operator()(const f32x4 (&acc)[2][2][4][2], const pg8::Unit& u, int wr, int wc, int fr, int fq) const {
#pragma unroll
    for (int ai = 0; ai < 2; ++ai)
#pragma unroll
      for (int m = 0; m < 4; ++m) {
        const int row = u.pm * 256 + ai * 128 + wr * 64 + m * 16 + fr;
        if (EPI == EPI_RW) {
          if (row < M) {
            float* sh = nullptr;
            if (row == TP - 1) sh = out + OUT4;
            else if (row == 2 * TP - 1) sh = out + OUT4 + RWP;
            else if (row >= MP && ((row - MP) & 63) == 63) sh = out + OUT7 + (long)((row - MP) >> 6) * RWP;
#pragma unroll
            for (int bj = 0; bj < 2; ++bj)
#pragma unroll
              for (int n = 0; n < 2; ++n) {
                const int nl = u.pn * 256 + bj * 128 + wc * 32 + n * 16 + fq * 4 - 128;
                if (nl >= 0) {
                  f32x4 a = acc[ai][bj][m][n];
                  uint2 o;
                  o.x = pack2(a[0], a[1]); o.y = pack2(a[2], a[3]);
                  *(uint2*)(RA + (long)row * RWP + nl) = o;
                  if (sh) { float4 f = {a[0], a[1], a[2], a[3]}; *(float4*)(sh + nl) = f; }
                }
              }
          }
        } else if (EPI == EPI_HG) {
          if (row < M) {
            const int grp = u.pn >> 2;
#pragma unroll
            for (int bj = 0; bj < 2; ++bj)
#pragma unroll
              for (int n = 0; n < 2; ++n) {
                const int nn = u.pn * 256 + bj * 128 + wc * 32 + n * 16 + fq * 4;
                const int c = nn & 1023;
                f32x4 a = acc[ai][bj][m][n];
                float r[4];
                if (grp == 0 || grp == 3) {
#pragma unroll
                  for (int e = 0; e < 4; ++e) r[e] = a[e] * sigmoidf_(a[e]);
                } else if (grp == 1) {
                  {
                    const float4 om = *(const float4*)(hlb + c);
                    r[0] = om.x * sigmoidf_(-a[0]); r[1] = om.y * sigmoidf_(-a[1]);
                    r[2] = om.z * sigmoidf_(-a[2]); r[3] = om.w * sigmoidf_(-a[3]);
                  }
                } else {
#pragma unroll
                  for (int e = 0; e < 4; ++e) r[e] = a[e];
                }
                uint2 o;
                o.x = pack2(r[0], r[1]); o.y = pack2(r[2], r[3]);
                *(uint2*)(RA + (long)row * LDH + nn) = o;
              }
          }
        } else {
          long orow = -1;
          if (row < MP) {
            int b = row / TP, t = row - b * TP;
            if (t >= NMETA) orow = (long)b * SEQ + (t - NMETA);
          } else if (row < M) {
            orow = (long)NB * SEQ + (row - MP);
          }
          float ss = 0.f;
#pragma unroll
          for (int bj = 0; bj < 2; ++bj)
#pragma unroll
            for (int n = 0; n < 2; ++n) {
              const int nn = u.pn * 256 + bj * 128 + wc * 32 + n * 16 + fq * 4;
              f32x4 a = acc[ai][bj][m][n];
              ss += a[0] * a[0] + a[1] * a[1] + a[2] * a[2] + a[3] * a[3];
              if (orow >= 0) { uint2 o; o.x = pack2(a[0], a[1]); o.y = pack2(a[2], a[3]); *(uint2*)(RA + orow * D + nn) = o; }
            }
          ss += __shfl_xor(ss, 16);
          ss += __shfl_xor(ss, 32);
          if (fq == 0 && orow >= 0) atomicAdd(sumsq + row, ss);
        }
      }
  }
};

template <int EPI>
__device__ __forceinline__ void run_gemm(const Params& p, const u16* A, const u16* Bt, int N, char* smem) {
  pg8::Gemm g;
  g.A = A; g.Bt = Bt; g.M = MPAD; g.N = N; g.K = D; g.ld = LDU;
  pg8::StaticOrder S;
  S.init(MPAD, N, (int)gridDim.x, (int)blockIdx.x);
  Epi<EPI> E;
  E.RA = p.RA; E.out = p.out; E.hlb = p.omlb; E.sumsq = p.sumsq;
  pg8::gemm_phase<Epi<EPI>>((PG8_LAS unsigned char*)smem, g, S, E);
}

__device__ void phase_rwprep(const Params& p, char* smem) {
  u16* twd = (u16*)smem;
  u16* xad = (u16*)(smem + 2304);
  u16* wl = (u16*)(smem + 8192);
  u16* al = wl + 16384;
  const int tid = threadIdx.x, lane = tid & 63, wave = tid >> 6;
  const int fr = lane & 15, fq = lane >> 4;
  const int th = tid >> 8, cg = tid & 255, c0 = cg * 4;
  const u16* raw = p.RA;
  const float4 mu_r = *(const float4*)(p.mu + c0), mu_k = *(const float4*)(p.mu + 1024 + c0),
               mu_v = *(const float4*)(p.mu + 2048 + c0), mu_g = *(const float4*)(p.mu + 3072 + c0);
  const float4 w0 = *(const float4*)(p.w0 + c0), a0 = *(const float4*)(p.a0 + c0), kkc = *(const float4*)(p.k_k + c0),
               kac = *(const float4*)(p.k_a + c0), rkc = *(const float4*)(p.r_k + c0);
  for (int tile = blockIdx.x; tile < M / 16; tile += gridDim.x) {
    const int row0 = tile * 16;
    int seq_start;
    const float* shiftp = nullptr;
    if (row0 < MP) { int b = row0 / TP; seq_start = b * TP; }
    else { int sb = (row0 - MP) >> 6; seq_start = MP + sb * 64; shiftp = p.state_shift + (long)sb * RWP; }
    const bool first = (row0 == seq_start);
#pragma unroll
    for (int i = 0; i < 4; ++i) {
      int e = tid + 512 * i;
      int t = e >> 7, c = e & 127, col = 4096 + c;
      float pc = bf2f(raw[(long)(row0 + t) * RWP + col]);
      float pp;
      if (t == 0 && first) pp = shiftp ? shiftp[col] : 0.f;
      else pp = bf2f(raw[(long)(row0 + t - 1) * RWP + col]);
      float xm = pc + (pp - pc) * p.mu[col];
      if (c < 64) twd[t * 72 + c] = f2bf(tanhf_(xm));
      else xad[t * 72 + (c - 64)] = f2bf(xm);
    }
    __syncthreads();
    {
      bf16x8_t aw[2], aa[2];
#pragma unroll
      for (int ks = 0; ks < 2; ++ks) {
        aw[ks] = *(const bf16x8_t*)(twd + fr * 72 + ks * 32 + fq * 8);
        aa[ks] = *(const bf16x8_t*)(xad + fr * 72 + ks * 32 + fq * 8);
      }
#pragma unroll
      for (int nt = 0; nt < 8; ++nt) {
        const int n0 = wave * 128 + nt * 16;
        f32x4 accw = {0.f, 0.f, 0.f, 0.f}, acca = {0.f, 0.f, 0.f, 0.f};
#pragma unroll
        for (int ks = 0; ks < 2; ++ks) {
          bf16x8_t bw = *(const bf16x8_t*)(p.w2T + (n0 + fr) * 64 + ks * 32 + fq * 8);
          bf16x8_t ba = *(const bf16x8_t*)(p.a2T + (n0 + fr) * 64 + ks * 32 + fq * 8);
          accw = __builtin_amdgcn_mfma_f32_16x16x32_bf16(aw[ks], bw, accw, 0, 0, 0);
          acca = __builtin_amdgcn_mfma_f32_16x16x32_bf16(aa[ks], ba, acca, 0, 0, 0);
        }
#pragma unroll
        for (int e = 0; e < 4; ++e) {
          wl[(fq * 4 + e) * 1024 + n0 + fr] = f2bf(accw[e]);
          al[(fq * 4 + e) * 1024 + n0 + fr] = f2bf(acca[e]);
        }
      }
    }
    __syncthreads();
    {
      const int t0 = th * 8;
      float pr[4], pk[4], pv[4], pg[4];
      float Wl[4] = {1.f, 1.f, 1.f, 1.f};
      if (t0 == 0 && first) {
        if (shiftp) {
          float4 a = *(const float4*)(shiftp + c0), b = *(const float4*)(shiftp + 1024 + c0),
                 c = *(const float4*)(shiftp + 2048 + c0), d = *(const float4*)(shiftp + 3072 + c0);
          pr[0] = a.x; pr[1] = a.y; pr[2] = a.z; pr[3] = a.w; pk[0] = b.x; pk[1] = b.y; pk[2] = b.z; pk[3] = b.w;
          pv[0] = c.x; pv[1] = c.y; pv[2] = c.z; pv[3] = c.w; pg[0] = d.x; pg[1] = d.y; pg[2] = d.z; pg[3] = d.w;
        } else {
#pragma unroll
          for (int j = 0; j < 4; ++j) pr[j] = pk[j] = pv[j] = pg[j] = 0.f;
        }
      } else {
        const u16* rp = raw + (long)(row0 + t0 - 1) * RWP + c0;
        uint2 a = *(const uint2*)(rp), b = *(const uint2*)(rp + 1024), c = *(const uint2*)(rp + 2048), d = *(const uint2*)(rp + 3072);
        pr[0] = bflo(a.x); pr[1] = bfhi(a.x); pr[2] = bflo(a.y); pr[3] = bfhi(a.y);
        pk[0] = bflo(b.x); pk[1] = bfhi(b.x); pk[2] = bflo(b.y); pk[3] = bfhi(b.y);
        pv[0] = bflo(c.x); pv[1] = bfhi(c.x); pv[2] = bflo(c.y); pv[3] = bfhi(c.y);
        pg[0] = bflo(d.x); pg[1] = bfhi(d.x); pg[2] = bflo(d.y); pg[3] = bfhi(d.y);
      }
      const float mur[4] = {mu_r.x, mu_r.y, mu_r.z, mu_r.w}, muk[4] = {mu_k.x, mu_k.y, mu_k.z, mu_k.w},
                  muv[4] = {mu_v.x, mu_v.y, mu_v.z, mu_v.w}, mug[4] = {mu_g.x, mu_g.y, mu_g.z, mu_g.w};
      const float w0a[4] = {w0.x, w0.y, w0.z, w0.w}, a0a[4] = {a0.x, a0.y, a0.z, a0.w}, kka[4] = {kkc.x, kkc.y, kkc.z, kkc.w},
                  kaa[4] = {kac.x, kac.y, kac.z, kac.w}, rka[4] = {rkc.x, rkc.y, rkc.z, rkc.w};
#pragma unroll
      for (int tt = 0; tt < 8; ++tt) {
        const int t = t0 + tt;
        const u16* rp = raw + (long)(row0 + t) * RWP + c0;
        uint2 ua = *(const uint2*)(rp), ub = *(const uint2*)(rp + 1024), uc = *(const uint2*)(rp + 2048), ud = *(const uint2*)(rp + 3072);
        uint2 ul = *(const uint2*)(wl + t * 1024 + c0), ula = *(const uint2*)(al + t * 1024 + c0);
        const float cr[4] = {bflo(ua.x), bfhi(ua.x), bflo(ua.y), bfhi(ua.y)}, ck[4] = {bflo(ub.x), bfhi(ub.x), bflo(ub.y), bfhi(ub.y)},
                    cv[4] = {bflo(uc.x), bfhi(uc.x), bflo(uc.y), bfhi(uc.y)}, cgt[4] = {bflo(ud.x), bfhi(ud.x), bflo(ud.y), bfhi(ud.y)},
                    lw[4] = {bflo(ul.x), bfhi(ul.x), bflo(ul.y), bfhi(ul.y)}, la[4] = {bflo(ula.x), bfhi(ula.x), bflo(ula.y), bfhi(ula.y)};
        float xr[4], xk[4], xv[4], gs[4], ee[4], aa_[4], kkr[4], kp[4];
        float ss = 0.f, bon = 0.f;
#pragma unroll
        for (int j = 0; j < 4; ++j) {
          xr[j] = cr[j] + (pr[j] - cr[j]) * mur[j];
          xk[j] = ck[j] + (pk[j] - ck[j]) * muk[j];
          xv[j] = cv[j] + (pv[j] - cv[j]) * muv[j];
          float xg = cgt[j] + (pg[j] - cgt[j]) * mug[j];
          pr[j] = cr[j]; pk[j] = ck[j]; pv[j] = cv[j]; pg[j] = cgt[j];
          ee[j] = 1.0f - __expf(-0.60653066f * sigmoidf_(w0a[j] + lw[j]));
          aa_[j] = sigmoidf_(a0a[j] + la[j]);
          kkr[j] = xk[j] * kka[j];
          ss += kkr[j] * kkr[j];
          kp[j] = xk[j] * (1.0f + (aa_[j] - 1.0f) * kaa[j]);
          bon += xr[j] * kp[j] * rka[j];
          gs[j] = xg * sigmoidf_(xg);
        }
        ss = allreduce16(ss);
        bon = allreduce16(bon);
        const float inv = rsqrtf(fmaxf(ss, 1e-24f));
        if (fr == 0) p.bonus[(long)(row0 + t) * 16 + (cg >> 4)] = bon;
        float kk[4], bb[4], rs_[4], ks_[4];
#pragma unroll
        for (int j = 0; j < 4; ++j) {
          const float Wp = Wl[j];
          Wl[j] *= (1.0f - ee[j]);
          const float iw = frcp(Wl[j]);
          const float kkn = kkr[j] * inv;
          kk[j] = kkn * Wp;
          bb[j] = kkn * aa_[j] * iw;
          rs_[j] = xr[j] * Wl[j];
          ks_[j] = kp[j] * iw;
        }
        const long po = (long)(row0 + t) * LDP + c0;
        uint2 o;
        o.x = pack2(rs_[0], rs_[1]); o.y = pack2(rs_[2], rs_[3]); *(uint2*)(p.pl_r + po) = o;
        o.x = pack2(ks_[0], ks_[1]); o.y = pack2(ks_[2], ks_[3]); *(uint2*)(p.pl_k + po) = o;
        o.x = pack2(xv[0], xv[1]); o.y = pack2(xv[2], xv[3]); *(uint2*)(p.pl_v + po) = o;
        o.x = pack2(kk[0], kk[1]); o.y = pack2(kk[2], kk[3]); *(uint2*)(p.pl_kk + po) = o;
        o.x = pack2(bb[0], bb[1]); o.y = pack2(bb[2], bb[3]); *(uint2*)(p.pl_b + po) = o;
        o.x = pack2(gs[0], gs[1]); o.y = pack2(gs[2], gs[3]); *(uint2*)(p.pl_g + po) = o;
      }
      {
        float4 gw = {Wl[0], Wl[1], Wl[2], Wl[3]};
        *(float4*)(p.Gp + (long)((row0 + t0) >> 3) * 1024 + c0) = gw;
      }
    }
    __syncthreads();
  }
}

__device__ void rwkv_unit(const Params& p, float* sm, int row0, int len, int h, int q, const float* S0,
                          float* Sout) {
  const int tid = threadIdx.x, wave = tid >> 6, lane = tid & 63;
  float* buf = sm;
  float* vT = sm + 16384;
  float* ybuf = sm + 17408;
  float* wend = sm + 18432;
  float* dummyb = sm + 18560;
  const int ntiles = (len + 31) >> 5;
  if (wave < 4) {
    const int rA = wave * 4 + (lane >> 4);
    const int c4 = (lane & 15) * 4;
    f32x2 A01 = {0.f, 0.f}, A23 = {0.f, 0.f};
    if (S0) {
      float4 sa_ = *(const float4*)(S0 + (q * 16 + rA) * 64 + c4);
      A01 = (f32x2){sa_.x, sa_.y}; A23 = (f32x2){sa_.z, sa_.w};
    }
    __syncthreads();
    const int l15 = lane & 15;
    const bool odd1 = (lane & 1) != 0, odd2 = (lane & 2) != 0;
    for (int i = 0; i < ntiles; ++i) {
      const int steps = min(32, len - i * 32);
      const float* bp = buf + (i & 1) * 8192 + c4;
      const float* vpA = vT + (i & 1) * 512 + rA * 32;
      float* yw = (l15 < 4) ? (ybuf + (i & 1) * 512 + (lane & 3) * 16 + rA) : (dummyb + lane);
      f32x4 r4 = *(const f32x4*)(bp), k4 = *(const f32x4*)(bp + 64), kk4 = *(const f32x4*)(bp + 128),
            b4 = *(const f32x4*)(bp + 192);
      f32x4 vA4 = *(const f32x4*)(vpA), nvA4 = vA4;
      float yp[4] = {0.f, 0.f, 0.f, 0.f};
#pragma unroll 1
      for (int s4 = 0; s4 < steps; s4 += 4) {
#pragma unroll
        for (int j4 = 0; j4 < 4; ++j4) {
          const int s = s4 + j4;
          const float* sp = bp + (s + 1) * 256;
          f32x4 nr4 = *(const f32x4*)(sp), nk4 = *(const f32x4*)(sp + 64), nkk4 = *(const f32x4*)(sp + 128),
                nb4 = *(const f32x4*)(sp + 192);
          if (j4 == 0) nvA4 = *(const f32x4*)(vpA + ((s + 4) & 31));
          const f32x2 kk01 = {kk4[0], kk4[1]}, kk23 = {kk4[2], kk4[3]}, k01 = {k4[0], k4[1]}, k23 = {k4[2], k4[3]},
                      b01 = {b4[0], b4[1]}, b23 = {b4[2], b4[3]}, r01 = {r4[0], r4[1]}, r23 = {r4[2], r4[3]};
          f32x2 tA = A01 * kk01;
          tA = __builtin_elementwise_fma(A23, kk23, tA);
          const f32x2 vA2 = {vA4[j4], vA4[j4]};
          A01 = __builtin_elementwise_fma(vA2, k01, A01);
          A23 = __builtin_elementwise_fma(vA2, k23, A23);
          const float saA = allreduce16(tA[0] + tA[1]);
          const f32x2 sA2 = {saA, saA};
          A01 = __builtin_elementwise_fma(-sA2, b01, A01);
          A23 = __builtin_elementwise_fma(-sA2, b23, A23);
          f32x2 uA = A01 * r01;
          uA = __builtin_elementwise_fma(A23, r23, uA);
          yp[j4] = uA[0] + uA[1];
          if (j4 == 3) {
            float a = odd1 ? yp[1] : yp[0], bs = odd1 ? yp[0] : yp[1];
            float c = odd1 ? yp[3] : yp[2], ds = odd1 ? yp[2] : yp[3];
            a += __int_as_float(__builtin_amdgcn_update_dpp(0, __float_as_int(bs), 0xB1, 0xF, 0xF, true));
            c += __int_as_float(__builtin_amdgcn_update_dpp(0, __float_as_int(ds), 0xB1, 0xF, 0xF, true));
            float e = odd2 ? c : a, fs = odd2 ? a : c;
            e += __int_as_float(__builtin_amdgcn_update_dpp(0, __float_as_int(fs), 0x4E, 0xF, 0xF, true));
            e = dpp_add<0x124>(e);
            e = dpp_add<0x128>(e);
            yw[s4 * 16] = e;
          }
          r4 = nr4; k4 = nk4; kk4 = nkk4; b4 = nb4;
          if (j4 == 3) vA4 = nvA4;
        }
      }
      {
        f32x4 we = *(const f32x4*)(wend + (i & 1) * 64 + c4);
        A01 *= (f32x2){we[0], we[1]}; A23 *= (f32x2){we[2], we[3]};
      }
      __syncthreads();
    }
    float4 so = {A01[0], A01[1], A23[0], A23[1]};
    *(float4*)(Sout + (q * 16 + rA) * 64 + c4) = so;
  } else {
    const int ht = tid - 256;
    const int c = ht & 63, role = ht >> 6;
    const int vstep = ht >> 1, vch = ht & 1;
    const int urole = __builtin_amdgcn_readfirstlane(role);
    const u16* pl = (urole == 0) ? p.pl_r : (urole == 1) ? p.pl_k : (urole == 2) ? p.pl_kk : p.pl_b;
    u16 pp[32];
    float G[4] = {1.f, 1.f, 1.f, 1.f};
    uint4 rv = {0u, 0u, 0u, 0u};
    auto gload = [&](int i) {
      if (i >= ntiles) return;
      const u16* base = pl + (long)(row0 + i * 32) * LDP + h * 64;
#pragma unroll
      for (int t = 0; t < 32; ++t) pp[t] = base[t * LDP + c];
      const float* gbase = p.Gp + (long)((row0 + i * 32) >> 3) * 1024 + h * 64;
#pragma unroll
      for (int g = 0; g < 4; ++g) G[g] = gbase[g * 1024 + c];
      if (ht < 64) rv = *(const uint4*)(p.pl_v + (long)(row0 + i * 32 + vstep) * LDP + h * 64 + q * 16 + vch * 8);
    };
    auto lwrite = [&](int i) {
      float* bp = buf + (i & 1) * 8192 + role * 64 + c;
      const int ngroups = min(32, len - i * 32) >> 3;
      float Wg[4];
      Wg[0] = 1.0f; Wg[1] = G[0]; Wg[2] = Wg[1] * G[1]; Wg[3] = Wg[2] * G[2];
      const float Wall = Wg[3] * G[3];
      float m[4];
#pragma unroll
      for (int g = 0; g < 4; ++g) m[g] = (role == 0 || role == 2) ? Wg[g] : frcp(Wg[g]);
#pragma unroll
      for (int t = 0; t < 32; ++t) bp[t * 256] = bf2f(pp[t]) * m[t >> 3];
      if (role == 0) wend[(i & 1) * 64 + c] = (ngroups >= 4) ? Wall : Wg[ngroups & 3];
      if (ht < 64) {
        float* vt = vT + (i & 1) * 512 + (vch * 8) * 32 + vstep;
        vt[0] = bflo(rv.x); vt[32] = bfhi(rv.x); vt[64] = bflo(rv.y); vt[96] = bfhi(rv.y);
        vt[128] = bflo(rv.z); vt[160] = bfhi(rv.z); vt[192] = bflo(rv.w); vt[224] = bfhi(rv.w);
      }
    };
    auto yflush = [&](int i) {
      if (ht < 64 && (i * 32 + vstep) < len) {
        const float* yb = ybuf + (i & 1) * 512 + vstep * 16 + vch * 8;
        float4 a = *(const float4*)yb, b = *(const float4*)(yb + 4);
        uint4 o;
        o.x = pack2(a.x, a.y); o.y = pack2(a.z, a.w); o.z = pack2(b.x, b.y); o.w = pack2(b.z, b.w);
        *(uint4*)(p.U + (long)(row0 + i * 32 + vstep) * LDU + 1024 + h * 64 + q * 16 + vch * 8) = o;
      }
    };
    gload(0);
    lwrite(0);
    gload(1);
    __syncthreads();
    for (int i = 0; i < ntiles; ++i) {
      if (i + 1 < ntiles) lwrite(i + 1);
      gload(i + 2);
      if (i >= 1) yflush(i - 1);
      __syncthreads();
    }
    yflush(ntiles - 1);
  }
  __syncthreads();
}

__device__ void hgrn_unit(const Params& p, float* sm, int row0, int len, int h, int vs, const float* S0,
                          float* Sout) {
  const int tid = threadIdx.x, wave = tid >> 6, lane = tid & 63;
  float* buf = sm;
  float* vT = sm + 16384;
  float* opart = sm + 17408;
  const u16* P = p.RA;
  const int ntiles = (len + 31) >> 5;
  if (wave < 4) {
    const int kg = lane & 3, vcol = lane >> 2;
    const int krow0 = wave * 32 + kg * 8;
    f32x2 S[4] = {{0.f, 0.f}, {0.f, 0.f}, {0.f, 0.f}, {0.f, 0.f}};
    if (S0) {
      const float* s0 = S0 + (long)krow0 * 128 + vs * 16 + vcol;
#pragma unroll
      for (int j = 0; j < 4; ++j) S[j] = (f32x2){s0[(2 * j) * 128], s0[(2 * j + 1) * 128]};
    }
    __syncthreads();
    const bool odd1 = (lane & 1) != 0, odd2 = (lane & 2) != 0;
    for (int i = 0; i < ntiles; ++i) {
      const int steps = min(32, len - i * 32);
      const float* bp = buf + (i & 1) * 8192 + krow0;
      const float* vp = vT + (i & 1) * 512 + vcol * 32;
      float* ob = opart + (i & 1) * 2048 + kg * 64 + wave * 16 + vcol;
      f32x4 qa = *(const f32x4*)(bp), qb = *(const f32x4*)(bp + 4), ka = *(const f32x4*)(bp + 128), kb = *(const f32x4*)(bp + 132);
      f32x4 v4 = *(const f32x4*)(vp), nv4 = v4;
      float op[4] = {0.f, 0.f, 0.f, 0.f};
#pragma unroll 1
      for (int s4 = 0; s4 < steps; s4 += 4) {
#pragma unroll
        for (int j4 = 0; j4 < 4; ++j4) {
          const int s = s4 + j4;
          const float* sp = bp + (s + 1) * 256;
          f32x4 nqa = *(const f32x4*)(sp), nqb = *(const f32x4*)(sp + 4), nka = *(const f32x4*)(sp + 128), nkb = *(const f32x4*)(sp + 132);
          if (j4 == 0) nv4 = *(const f32x4*)(vp + ((s + 4) & 31));
          const f32x2 vv2 = {v4[j4], v4[j4]};
          S[0] = __builtin_elementwise_fma((f32x2){ka[0], ka[1]}, vv2 - S[0], S[0]);
          S[1] = __builtin_elementwise_fma((f32x2){ka[2], ka[3]}, vv2 - S[1], S[1]);
          S[2] = __builtin_elementwise_fma((f32x2){kb[0], kb[1]}, vv2 - S[2], S[2]);
          S[3] = __builtin_elementwise_fma((f32x2){kb[2], kb[3]}, vv2 - S[3], S[3]);
          f32x2 u = S[0] * (f32x2){qa[0], qa[1]};
          u = __builtin_elementwise_fma(S[1], (f32x2){qa[2], qa[3]}, u);
          u = __builtin_elementwise_fma(S[2], (f32x2){qb[0], qb[1]}, u);
          u = __builtin_elementwise_fma(S[3], (f32x2){qb[2], qb[3]}, u);
          op[j4] = u[0] + u[1];
          if (j4 == 3) {
            float a = odd1 ? op[1] : op[0], bs = odd1 ? op[0] : op[1];
            float c = odd1 ? op[3] : op[2], ds = odd1 ? op[2] : op[3];
            a += __int_as_float(__builtin_amdgcn_update_dpp(0, __float_as_int(bs), 0xB1, 0xF, 0xF, true));
            c += __int_as_float(__builtin_amdgcn_update_dpp(0, __float_as_int(ds), 0xB1, 0xF, 0xF, true));
            float e = odd2 ? c : a, fs = odd2 ? a : c;
            e += __int_as_float(__builtin_amdgcn_update_dpp(0, __float_as_int(fs), 0x4E, 0xF, 0xF, true));
            ob[s4 * 64] = e;
          }
          qa = nqa; qb = nqb; ka = nka; kb = nkb;
          if (j4 == 3) v4 = nv4;
        }
      }
      __syncthreads();
    }
    {
      float* so = Sout + (long)krow0 * 128 + vs * 16 + vcol;
#pragma unroll
      for (int j = 0; j < 4; ++j) { so[(2 * j) * 128] = S[j][0]; so[(2 * j + 1) * 128] = S[j][1]; }
    }
  } else {
    const int ht = tid - 256;
    const int vstep = ht >> 1, vch = ht & 1;
    uint4 rq[2], rk[2], rv = {0u, 0u, 0u, 0u};
    auto gload = [&](int i) {
#pragma unroll
      for (int j = 0; j < 2; ++j) {
        const int cid = ht + 256 * j, step = cid >> 4, ch = cid & 15;
        const int tt = min(i * 32 + step, len - 1);
        const long off = (long)(row0 + tt) * LDH + h * 128 + ch * 8;
        rq[j] = *(const uint4*)(P + off);
        rk[j] = *(const uint4*)(P + off + 1024);
      }
      if (ht < 64) {
        int tv = min(i * 32 + vstep, len - 1);
        rv = *(const uint4*)(P + (long)(row0 + tv) * LDH + 2048 + h * 128 + vs * 16 + vch * 8);
      }
    };
    auto lwrite = [&](int i) {
      float* bp = buf + (i & 1) * 8192;
#pragma unroll
      for (int j = 0; j < 2; ++j) {
        const int cid = ht + 256 * j, step = cid >> 4, ch = cid & 15;
        unpack8_store(rq[j], bp + step * 256 + ch * 8);
        unpack8_store(rk[j], bp + step * 256 + 128 + ch * 8);
      }
      if (ht < 64) {
        float* vt = vT + (i & 1) * 512 + (vch * 8) * 32 + vstep;
        vt[0] = bflo(rv.x); vt[32] = bfhi(rv.x); vt[64] = bflo(rv.y); vt[96] = bfhi(rv.y);
        vt[128] = bflo(rv.z); vt[160] = bfhi(rv.z); vt[192] = bflo(rv.w); vt[224] = bfhi(rv.w);
      }
    };
    auto oflush = [&](int i) {
#pragma unroll
      for (int j = 0; j < 2; ++j) {
        const int oid = ht + 256 * j, st = oid >> 4, vc = oid & 15;
        if (i * 32 + st < len) {
          const float* op = opart + (i & 1) * 2048 + st * 64 + vc;
          float o = (op[0] + op[16]) + (op[32] + op[48]);
          p.U[(long)(row0 + i * 32 + st) * LDU + h * 128 + vs * 16 + vc] = f2bf(o);
        }
      }
    };
    gload(0);
    lwrite(0);
    gload(1);
    __syncthreads();
    for (int i = 0; i < ntiles; ++i) {
      if (i + 1 < ntiles) lwrite(i + 1);
      gload(i + 2);
      if (i >= 1) oflush(i - 1);
      __syncthreads();
    }
    oflush(ntiles - 1);
  }
  __syncthreads();
}

__device__ void phase_scan(const Params& p, char* smem) {
  float* sm = (float*)smem;
  volatile int* s_nextp = (volatile int*)(smem + 131008);
  for (int id = blockIdx.x; id < 256; id += gridDim.x) {
    if (id < 128) {
      int q = id >> 5, b = (id >> 4) & 1, h = id & 15;
      rwkv_unit(p, sm, b * TP, TP, h, q, nullptr, p.out + OUT3 + (long)(b * 16 + h) * 4096);
    } else {
      int j = id - 128;
      int vs = j >> 4, b = (j >> 3) & 1, h = j & 7;
      hgrn_unit(p, sm, b * TP, TP, h, vs, nullptr, p.out + OUT2 + (long)(b * 8 + h) * 16384);
    }
  }
  if (threadIdx.x == 0) *s_nextp = atomicAdd(p.queue, 1);
  __syncthreads();
  int jn = *s_nextp;
  __syncthreads();
  for (;;) {
    const int j0 = jn;
    if (j0 >= 4096) break;
    if (threadIdx.x == 0) *s_nextp = atomicAdd(p.queue, 1);
    if (j0 < 2048) {
      int j = j0;
      int b = j >> 6, h = (j >> 2) & 15, q = j & 3;
      rwkv_unit(p, sm, MP + b * 64, 64, h, q, p.state_rwkv + (long)(b * 16 + h) * 4096,
                p.out + OUT6 + (long)(b * 16 + h) * 4096);
    } else {
      int j = j0 - 2048;
      int b = j >> 6, h = (j >> 3) & 7, vs = j & 7;
      hgrn_unit(p, sm, MP + b * 64, 64, h, vs, p.state_hgrn + (long)(b * 8 + h) * 16384,
                p.out + OUT5 + (long)(b * 8 + h) * 16384);
    }
    jn = *s_nextp;
    __syncthreads();
  }
}

__device__ __forceinline__ void unpack16(const uint4& a, const uint4& b, float* f) {
  f[0] = bflo(a.x); f[1] = bfhi(a.x); f[2] = bflo(a.y); f[3] = bfhi(a.y); f[4] = bflo(a.z); f[5] = bfhi(a.z); f[6] = bflo(a.w); f[7] = bfhi(a.w);
  f[8] = bflo(b.x); f[9] = bfhi(b.x); f[10] = bflo(b.y); f[11] = bfhi(b.y); f[12] = bflo(b.z); f[13] = bfhi(b.z); f[14] = bflo(b.w); f[15] = bfhi(b.w);
}
__device__ __forceinline__ void pack16(const float* f, uint4& a, uint4& b) {
  a.x = pack2(f[0], f[1]); a.y = pack2(f[2], f[3]); a.z = pack2(f[4], f[5]); a.w = pack2(f[6], f[7]);
  b.x = pack2(f[8], f[9]); b.y = pack2(f[10], f[11]); b.z = pack2(f[12], f[13]); b.w = pack2(f[14], f[15]);
}
__device__ void phase_post(const Params& p) {
  const int tid = threadIdx.x, wave = tid >> 6, lane = tid & 63;
  const int c0 = lane * 16;
  float hgn[16], lnw[16], lnb[16];
#pragma unroll
  for (int j = 0; j < 16; ++j) { hgn[j] = p.hg_norm[c0 + j]; lnw[j] = p.ln_w[c0 + j]; lnb[j] = p.ln_b[c0 + j]; }
  for (int row = blockIdx.x * 8 + wave; row < M; row += gridDim.x * 8) {
    u16* mrow = p.U + (long)row * LDU;
    {
      const uint4* mp = (const uint4*)(mrow + c0);
      const uint4* gp = (const uint4*)(p.RA + (long)row * LDH + 3072 + c0);
      uint4 m0 = mp[0], m1 = mp[1], g0 = gp[0], g1 = gp[1];
      float o[16], g[16];
      unpack16(m0, m1, o);
      unpack16(g0, g1, g);
      float ss = 0.f;
#pragma unroll
      for (int j = 0; j < 16; ++j) ss += o[j] * o[j];
      ss = dpp_add<0xB1>(ss); ss = dpp_add<0x4E>(ss); ss = dpp_add<0x141>(ss);
      const float rs = rsqrtf(ss * (1.0f / 128.0f) + 1e-6f);
#pragma unroll
      for (int j = 0; j < 16; ++j) o[j] = o[j] * rs * hgn[j] * g[j];
      pack16(o, m0, m1);
      ((uint4*)(mrow + c0))[0] = m0;
      ((uint4*)(mrow + c0))[1] = m1;
    }
    {
      const uint4* yp = (const uint4*)(mrow + 1024 + c0);
      const uint4* vp = (const uint4*)(p.pl_v + (long)row * LDP + c0);
      const uint4* gp = (const uint4*)(p.pl_g + (long)row * LDP + c0);
      uint4 y0 = yp[0], y1 = yp[1], v0 = vp[0], v1 = vp[1], g0 = gp[0], g1 = gp[1];
      const float bon = p.bonus[(long)row * 16 + (lane >> 2)];
      float y[16], v[16], g[16];
      unpack16(y0, y1, y);
      unpack16(v0, v1, v);
      unpack16(g0, g1, g);
      float sm_ = 0.f;
#pragma unroll
      for (int j = 0; j < 16; ++j) sm_ += y[j];
      sm_ = allreduce4(sm_);
      const float mean = sm_ * (1.0f / 64.0f);
      float vs = 0.f;
#pragma unroll
      for (int j = 0; j < 16; ++j) { y[j] -= mean; vs += y[j] * y[j]; }
      vs = allreduce4(vs);
      const float rs = rsqrtf(vs * (1.0f / 64.0f) + 64e-5f);
#pragma unroll
      for (int j = 0; j < 16; ++j) y[j] = (y[j] * rs * lnw[j] + lnb[j] + bon * v[j]) * g[j];
      pack16(y, y0, y1);
      ((uint4*)(mrow + 1024 + c0))[0] = y0;
      ((uint4*)(mrow + 1024 + c0))[1] = y1;
    }
  }
}

__device__ void phase_final(const Params& p) {
  const long n4 = (OUT2) / 4;
  const long stride = (long)gridDim.x * blockDim.x;
  for (long idx = (long)blockIdx.x * blockDim.x + threadIdx.x; idx < n4; idx += stride) {
    long orow = idx >> 9;
    int c4 = (int)(idx & 511);
    int flat;
    const float* x;
    if (orow < (long)NB * SEQ) {
      int b = (int)(orow >> 14), t = (int)(orow & 16383);
      flat = b * TP + NMETA + t;
      x = p.x_prompt + orow * D;
    } else {
      flat = MP + (int)(orow - (long)NB * SEQ);
      x = p.x_sample + (orow - (long)NB * SEQ) * D;
    }
    float rstd = rsqrtf(p.sumsq[flat] * (1.0f / D) + 1e-6f);
    float4 xv = ((const float4*)x)[c4];
    float4 g = ((const float4*)p.norm_post)[c4];
    uint2 zb = ((const uint2*)p.RA)[idx];
    float4 o;
    o.x = xv.x + bflo(zb.x) * rstd * g.x; o.y = xv.y + bfhi(zb.x) * rstd * g.y;
    o.z = xv.z + bflo(zb.y) * rstd * g.z; o.w = xv.w + bfhi(zb.y) * rstd * g.w;
    ((float4*)p.out)[idx] = o;
  }
}

__device__ __forceinline__ void fast_grid_barrier(unsigned* ctr, unsigned target) {
  __syncthreads();
  if (threadIdx.x == 0) {
    __builtin_amdgcn_fence(__ATOMIC_RELEASE, "agent");
    asm volatile("s_waitcnt vmcnt(0) lgkmcnt(0)" ::: "memory");
    __hip_atomic_fetch_add(ctr, 1u, __ATOMIC_RELAXED, __HIP_MEMORY_SCOPE_AGENT);
    while (__hip_atomic_load(ctr, __ATOMIC_RELAXED, __HIP_MEMORY_SCOPE_AGENT) < target) __builtin_amdgcn_s_sleep(2);
    __builtin_amdgcn_fence(__ATOMIC_ACQUIRE, "agent");
    asm volatile("s_waitcnt vmcnt(0) lgkmcnt(0)" ::: "memory");
  }
  __syncthreads();
}

__global__ void __launch_bounds__(512) hymba_mega(Params p) {
  cg::grid_group grid = cg::this_grid();
  __shared__ __attribute__((aligned(1024))) char smem[SMEM_BYTES];
  phase_prep(p, smem);
  grid.sync();
  unsigned* bar = (unsigned*)(p.queue + 16);
  const unsigned nb = gridDim.x;
  run_gemm<EPI_RW>(p, p.U, p.WinT + (long)RW_COL0 * LDU, RWP + 128, smem);
  fast_grid_barrier(bar, 1u * nb);
  phase_rwprep(p, smem);
  fast_grid_barrier(bar, 2u * nb);
  run_gemm<EPI_HG>(p, p.U, p.WinT, HGP, smem);
  fast_grid_barrier(bar, 3u * nb);
  phase_scan(p, smem);
  fast_grid_barrier(bar, 4u * nb);
  phase_post(p);
  fast_grid_barrier(bar, 5u * nb);
  run_gemm<EPI_OUT>(p, p.U, p.WoutT, D, smem);
  fast_grid_barrier(bar, 6u * nb);
  phase_final(p);
}

extern "C" void kernel_launch(void* const* d_in, const int* in_sizes, int n_in, void* d_out, int out_size,
                              void* d_ws, size_t ws_size, hipStream_t stream) {
  static int grid_blocks = 0;
  if (!grid_blocks) {
    int dev = 0, cus = 0, per_cu = 0;
    (void)hipGetDevice(&dev);
    (void)hipDeviceGetAttribute(&cus, hipDeviceAttributeMultiprocessorCount, dev);
    (void)hipOccupancyMaxActiveBlocksPerMultiprocessor(&per_cu, hymba_mega, 512, 0);
    if (per_cu > 1) per_cu = 1;
    grid_blocks = cus * per_cu;
    grid_blocks -= grid_blocks % 8;
  }
  Params p{};
  const float* const* in = (const float* const*)d_in;
  p.x_prompt = in[0]; p.x_sample = in[1]; p.state_hgrn = in[2]; p.state_rwkv = in[3]; p.state_shift = in[4];
  p.meta = in[5]; p.norm_pre = in[6]; p.w_in = in[7]; p.hlb = in[8]; p.hg_norm = in[9]; p.mu = in[10];
  p.w0 = in[11]; p.w2 = in[12]; p.a0 = in[13]; p.a2 = in[14]; p.k_k = in[15]; p.k_a = in[16]; p.r_k = in[17];
  p.ln_w = in[18]; p.ln_b = in[19]; p.w_out = in[20]; p.norm_post = in[21];
  p.out = (float*)d_out;
  char* ws = (char*)d_ws;
  size_t off = 0;
  p.WinT = (u16*)(ws + off); off += (size_t)PT * LDU * 2;
  p.WoutT = (u16*)(ws + off); off += (size_t)D * LDU * 2;
  p.U = (u16*)(ws + off); off += (size_t)MPAD * LDU * 2;
  p.RA = (u16*)(ws + off); off += (size_t)MPAD * RWP * 2;
  const size_t plane = (size_t)M * LDP * 2;
  p.pl_r = (u16*)(ws + off); off += plane;
  p.pl_k = (u16*)(ws + off); off += plane;
  p.pl_v = (u16*)(ws + off); off += plane;
  p.pl_kk = (u16*)(ws + off); off += plane;
  p.pl_b = (u16*)(ws + off); off += plane;
  p.pl_e = (u16*)(ws + off); off += plane;
  p.pl_g = (u16*)(ws + off); off += plane;
  p.bonus = (float*)(ws + off); off += (size_t)M * 16 * 4;
  p.sumsq = (float*)(ws + off); off += (size_t)M * 4;
  p.queue = (int*)(ws + off); off += 256;
  p.w2T = (u16*)(ws + off); off += 1024 * 64 * 2;
  p.a2T = (u16*)(ws + off); off += 1024 * 64 * 2;
  p.Gp = (float*)(ws + off); off += (size_t)(M / 8) * 1024 * 4;
  p.omlb = (float*)(ws + off); off += 1024 * 4;
  if (off > ws_size) fprintf(stderr, "workspace too small: need %zu have %zu\n", off, ws_size);
  void* args[] = {&p};
  hipError_t e = hipLaunchCooperativeKernel((void*)hymba_mega, dim3(grid_blocks), dim3(512), args, 0, stream);
  if (e != hipSuccess) fprintf(stderr, "coop launch failed: %s (grid %d)\n", hipGetErrorString(e), grid_blocks);
}
```

```cpp
#include <hip/hip_runtime.h>
#include <hip/hip_cooperative_groups.h>
#include <cstdio>
namespace cg = cooperative_groups;

typedef __attribute__((ext_vector_type(8))) short bf16x8_t;
typedef __attribute__((ext_vector_type(4))) float f32x4;
typedef __attribute__((ext_vector_type(2))) float f32x2;
typedef __attribute__((ext_vector_type(2))) __bf16 bf16x2_t;
typedef unsigned short u16;
typedef unsigned int u32;

constexpr int D = 2048, NB = 2, SEQ = 16384, NMETA = 16, TP = SEQ + NMETA;
constexpr int DB = 32, DS = 64;
constexpr int MP = NB * TP;
constexpr int MS = DB * DS;
constexpr int M = MP + MS;
constexpr int MPAD = 35072;
constexpr int PT = 8320, HGP = 4096, RWP = 4224;
constexpr int LDU = 2112, LDH = 4160, LDP = 1088;
constexpr long OUT1 = 67108864L, OUT2 = 71303168L, OUT3 = 71565312L, OUT4 = 71696384L,
               OUT5 = 71704832L, OUT6 = 75899136L, OUT7 = 77996288L;
constexpr int SMEM_BYTES = 131072;

struct Params {
  const float *x_prompt, *x_sample, *state_hgrn, *state_rwkv, *state_shift, *meta, *norm_pre, *w_in,
      *hlb, *hg_norm, *mu, *w0, *w2, *a0, *a2, *k_k, *k_a, *r_k, *ln_w, *ln_b, *w_out, *norm_post;
  float* out;
  u16 *WinT, *WoutT, *U, *RA, *pl_r, *pl_k, *pl_v, *pl_kk, *pl_b, *pl_e, *pl_g;
  float *bonus, *sumsq;
  int* queue;
  u16 *w2T, *a2T;
  float* Gp;
  float* omlb;
};

__device__ __forceinline__ u32 pack2(float a, float b) {
  f32x2 v = {a, b};
  bf16x2_t r = __builtin_convertvector(v, bf16x2_t);
  return __builtin_bit_cast(u32, r);
}
__device__ __forceinline__ u16 f2bf(float a) { return (u16)(pack2(a, 0.f) & 0xffffu); }
__device__ __forceinline__ float bf2f(u16 v) { return __uint_as_float(((u32)v) << 16); }
__device__ __forceinline__ float bflo(u32 v) { return __uint_as_float(v << 16); }
__device__ __forceinline__ float bfhi(u32 v) { return __uint_as_float(v & 0xffff0000u); }
__device__ __forceinline__ float frcp(float x) { return __builtin_amdgcn_rcpf(x); }
__device__ __forceinline__ float sigmoidf_(float x) { return frcp(1.0f + __expf(-x)); }
__device__ __forceinline__ float tanhf_(float x) { return 1.0f - 2.0f * frcp(__expf(2.0f * x) + 1.0f); }
template <int CTRL>
__device__ __forceinline__ float dpp_add(float x) {
  int v = __builtin_amdgcn_update_dpp(0, __float_as_int(x), CTRL, 0xF, 0xF, true);
  return x + __int_as_float(v);
}
__device__ __forceinline__ float allreduce16(float x) {
  x = dpp_add<0xB1>(x);
  x = dpp_add<0x4E>(x);
  x = dpp_add<0x141>(x);
  x = dpp_add<0x140>(x);
  return x;
}
__device__ __forceinline__ float allreduce4(float x) {
  x = dpp_add<0xB1>(x);
  x = dpp_add<0x4E>(x);
  return x;
}
__device__ __forceinline__ float allreduce64(float x) {
  x = allreduce16(x);
  x += __shfl_xor(x, 16);
  x += __shfl_xor(x, 32);
  return x;
}
__device__ __forceinline__ void unpack8_store(uint4 u, float* d) {
  float4 a, b;
  a.x = bflo(u.x); a.y = bfhi(u.x); a.z = bflo(u.y); a.w = bfhi(u.y);
  b.x = bflo(u.z); b.y = bfhi(u.z); b.z = bflo(u.w); b.w = bfhi(u.w);
  *(float4*)d = a;
  *(float4*)(d + 4) = b;
}
__device__ __forceinline__ const float* row_src(const Params& p, int row) {
  if (row < MP) {
    int b = row / TP, t = row - b * TP;
    if (t < NMETA) return p.meta + (long)t * D;
    return p.x_prompt + ((long)b * SEQ + (t - NMETA)) * D;
  }
  return p.x_sample + (long)(row - MP) * D;
}

__device__ void phase_prep(const Params& p, char* smem) {
  float* tile = (float*)smem;
  const int tid = threadIdx.x, wave = tid >> 6, lane = tid & 63;
  const int ntile_in = 32 * 130, ntile_out = 32 * 32;
  for (int t = blockIdx.x; t < ntile_in + ntile_out; t += gridDim.x) {
    const float* W; u16* WT; int N, tk, tn;
    if (t < ntile_in) { W = p.w_in; WT = p.WinT; N = PT; tk = t / 130; tn = t - tk * 130; }
    else { int tt = t - ntile_in; W = p.w_out; WT = p.WoutT; N = D; tk = tt >> 5; tn = tt & 31; }
#pragma unroll
    for (int i = 0; i < 8; ++i) {
      int k = (tid >> 6) + 8 * i;
      tile[k * 65 + (tid & 63)] = W[(long)(tk * 64 + k) * N + tn * 64 + (tid & 63)];
    }
    __syncthreads();
    {
      int n = tid >> 3, kc = (tid & 7) * 8;
      float v[8];
#pragma unroll
      for (int j = 0; j < 8; ++j) v[j] = tile[(kc + j) * 65 + n];
      uint4 o;
      o.x = pack2(v[0], v[1]); o.y = pack2(v[2], v[3]); o.z = pack2(v[4], v[5]); o.w = pack2(v[6], v[7]);
      *(uint4*)(WT + (long)(tn * 64 + n) * LDU + tk * 64 + kc) = o;
    }
    __syncthreads();
  }
  for (int row = blockIdx.x * 8 + wave; row < MPAD; row += gridDim.x * 8) {
    u16* dst = p.U + (long)row * LDU;
    if (row >= M) {
      uint2 z = {0u, 0u};
#pragma unroll
      for (int i = 0; i < 8; ++i) ((uint2*)dst)[lane + 64 * i] = z;
      continue;
    }
    const float4* src = (const float4*)row_src(p, row);
    float4 v[8];
    float ss = 0.f;
#pragma unroll
    for (int i = 0; i < 8; ++i) {
      v[i] = src[lane + 64 * i];
      ss += v[i].x * v[i].x + v[i].y * v[i].y + v[i].z * v[i].z + v[i].w * v[i].w;
    }
    ss = allreduce64(ss);
    float rstd = rsqrtf(ss * (1.0f / D) + 1e-6f);
#pragma unroll
    for (int i = 0; i < 8; ++i) {
      float4 g = ((const float4*)p.norm_pre)[lane + 64 * i];
      uint2 o;
      o.x = pack2(v[i].x * rstd * g.x, v[i].y * rstd * g.y);
      o.y = pack2(v[i].z * rstd * g.z, v[i].w * rstd * g.w);
      ((uint2*)dst)[lane + 64 * i] = o;
    }
  }
  for (int i = blockIdx.x * blockDim.x + tid; i < M; i += gridDim.x * blockDim.x) p.sumsq[i] = 0.f;
  if (blockIdx.x == 0 && tid == 0) { p.queue[0] = 0; p.queue[16] = 0; }
  if (blockIdx.x == 1) for (int i = tid; i < 1024; i += blockDim.x) p.omlb[i] = 1.0f - sigmoidf_(p.hlb[i] - p.hlb[1024 + i]);
  for (int i = blockIdx.x * blockDim.x + tid; i < 65536; i += gridDim.x * blockDim.x) {
    int n = i >> 6, k = i & 63;
    p.w2T[i] = f2bf(p.w2[k * 1024 + n]);
    p.a2T[i] = f2bf(p.a2[k * 1024 + n]);
  }
}

namespace pg8 {
#define PG8_LAS __attribute__((address_space(3)))
constexpr int BM = 256, BK = 64, HALF = 128, HTB = HALF * BK * 2, STAGE_BYTES = 8 * HTB, NXCD = 8, WGM = 8;
__device__ __forceinline__ int lds_byte(int r, int c) { const int st = (r >> 4) * 2 + (c >> 5), rr = r & 15, cc = c & 31, ob = rr * 64 + cc * 2; return st * 1024 + (ob ^ (((ob >> 9) & 1) << 5)); }
__device__ __forceinline__ void stage_rc(int b, int& R, int& C) { const int st = b / 1024, sb = b % 1024, swz = sb ^ (((sb >> 9) & 1) << 5); R = (st >> 1) * 16 + swz / 64; C = (st & 1) * 32 + (swz % 64) / 2; }
struct Unit { int pm, pn; };
struct Gemm { const u16* A; const u16* Bt; int M, N, K, ld; };
struct StaticOrder {
  int nM, nN, nwg, G, c;
  __device__ void init(int M_, int N_, int G_, int c_) { nM = M_ / BM; nN = N_ / BM; nwg = nM * nN; G = G_; c = c_; }
  __device__ bool next(int i, Unit& u) const {
    const long L = (long)i * G + c; if (L >= nwg) return false;
    int wgid = (int)L; { const int q = nwg / NXCD, r = nwg % NXCD, xcd = wgid % NXCD, off = wgid / NXCD; wgid = (xcd < r ? xcd * (q + 1) : r * (q + 1) + (xcd - r) * q) + off; }
    const int nig = WGM * nN, gid = wgid / nig, fm = gid * WGM, gsz = (nM - fm) < WGM ? (nM - fm) : WGM;
    u.pm = fm + ((wgid % nig) % gsz); u.pn = (wgid % nig) / gsz; return true;
  }
};

template <class Epi>
__device__ __forceinline__ void gemm_phase(PG8_LAS unsigned char* lds, const Gemm g, const StaticOrder& S, const Epi& E) {
  const int tid = threadIdx.x, wid = __builtin_amdgcn_readfirstlane(tid >> 6), lane = tid & 63, wr = wid >> 2, wc = wid & 3, fr = lane & 15, fq = lane >> 4;
  const int K = g.K, nt = K / BK, ld = g.ld;
  unsigned voffA[2], voffB[2];
#pragma unroll
  for (int i = 0; i < 2; ++i) { int R, C; stage_rc(tid * 16 + i * 8192, R, C); voffA[i] = (unsigned)(R * ld + C) * 2u; voffB[i] = voffA[i]; }
  const size_t kstep = (size_t)(BK * 2);
  const size_t hstep = (size_t)HALF * ld * 2;
  const size_t tstep = 2 * hstep;
  const unsigned ldsw = (unsigned)wid * 1024u;
  const int aoff = lds_byte(wr * 64 + fr, fq * 8), boff = lds_byte(wc * 32 + fr, fq * 8);
#define PG8_SA(b, h) (((b) * 2 + (h)) * HTB)
#define PG8_SB(b, h) ((4 + (b) * 2 + (h)) * HTB)
#define PG8_STAGE(bufoff, gbase, voff) do { _Pragma("unroll") for (int _i = 0; _i < 2; ++_i) \
    __builtin_amdgcn_global_load_lds((const unsigned*)((const char*)(gbase) + (voff)[_i]), (PG8_LAS unsigned*)(lds + (bufoff) + ldsw + _i * 8192), 16, 0, 0); } while (0)
#define PG8_LDA(dst, b, h) do { _Pragma("unroll") for (int m = 0; m < 4; ++m) _Pragma("unroll") for (int k = 0; k < 2; ++k) dst[m][k] = *(const PG8_LAS bf16x8_t*)(lds + PG8_SA(b, h) + aoff + m * 2048 + k * 1024); } while (0)
#define PG8_LDB(dst, b, h) do { _Pragma("unroll") for (int n = 0; n < 2; ++n) _Pragma("unroll") for (int k = 0; k < 2; ++k) dst[n][k] = *(const PG8_LAS bf16x8_t*)(lds + PG8_SB(b, h) + boff + n * 2048 + k * 1024); } while (0)
#define PG8_MMA(ai, bj, At, Bt) do { __builtin_amdgcn_s_setprio(1); _Pragma("unroll") for (int m = 0; m < 4; ++m) _Pragma("unroll") for (int n = 0; n < 2; ++n) _Pragma("unroll") for (int k = 0; k < 2; ++k) \
    acc[ai][bj][m][n] = __builtin_amdgcn_mfma_f32_16x16x32_bf16(Bt[n][k], At[m][k], acc[ai][bj][m][n], 0, 0, 0); __builtin_amdgcn_s_setprio(0); } while (0)
#define PG8_WAIT_V(n) asm volatile("s_waitcnt vmcnt(" #n ")" ::: "memory")
#define PG8_WAIT_L(n) asm volatile("s_waitcnt lgkmcnt(" #n ")" ::: "memory")
#define PG8_BAR __builtin_amdgcn_s_barrier()
#define PG8_SCHED __builtin_amdgcn_sched_barrier(0)
  Unit cur, nxt; int ui = 0;
  if (!S.next(0, cur)) return;
  f32x4 acc[2][2][4][2];
#pragma unroll
  for (int a = 0; a < 2; ++a)
#pragma unroll
    for (int b = 0; b < 2; ++b)
#pragma unroll
      for (int m = 0; m < 4; ++m)
#pragma unroll
        for (int n = 0; n < 2; ++n) acc[a][b][m][n] = (f32x4){0.f, 0.f, 0.f, 0.f};
  bf16x8_t At[4][2], B0[2][2], B1[2][2];
  const char* cA = (const char*)g.A + (size_t)cur.pm * tstep; const char* cB = (const char*)g.Bt + (size_t)cur.pn * tstep;
  PG8_STAGE(PG8_SB(0, 0), cB, voffB); PG8_STAGE(PG8_SA(0, 0), cA, voffA); PG8_STAGE(PG8_SB(0, 1), cB + hstep, voffB); PG8_STAGE(PG8_SA(0, 1), cA + hstep, voffA);
  if (wr == 1) PG8_BAR;
  PG8_WAIT_V(4); PG8_BAR;
  PG8_STAGE(PG8_SB(1, 0), cB + kstep, voffB); PG8_STAGE(PG8_SA(1, 0), cA + kstep, voffA); PG8_STAGE(PG8_SB(1, 1), cB + hstep + kstep, voffB);
  PG8_WAIT_V(6); PG8_BAR;
  for (;;) {
    const bool has_next = S.next(ui + 1, nxt);
    const char* nA = has_next ? (const char*)g.A + (size_t)nxt.pm * tstep : cA; const char* nB = has_next ? (const char*)g.Bt + (size_t)nxt.pn * tstep : cB;
    for (int t = 0; t < nt; t += 2) {
      const bool last = (t == nt - 2);
      const char* a1 = cA + (size_t)(t + 1) * kstep;
      const char* a2 = last ? nA : cA + (size_t)(t + 2) * kstep; const char* b2 = last ? nB : cB + (size_t)(t + 2) * kstep;
      const char* a3 = a2 + kstep; const char* b3 = b2 + kstep;
      PG8_LDB(B0, 0, 0); PG8_SCHED; PG8_LDA(At, 0, 0); PG8_STAGE(PG8_SA(1, 1), a1 + hstep, voffA);
      PG8_WAIT_L(8); PG8_BAR; PG8_WAIT_L(0); PG8_MMA(0, 0, At, B0); PG8_BAR; PG8_SCHED;
      PG8_LDB(B1, 0, 1); PG8_STAGE(PG8_SB(0, 0), b2, voffB);
      PG8_BAR; PG8_WAIT_L(0); PG8_MMA(0, 1, At, B1); PG8_BAR;
      PG8_LDA(At, 0, 1); PG8_STAGE(PG8_SA(0, 0), a2, voffA);
      PG8_BAR; PG8_WAIT_L(0); PG8_MMA(1, 0, At, B0); PG8_BAR; PG8_SCHED;
      PG8_STAGE(PG8_SB(0, 1), b2 + hstep, voffB);
      PG8_WAIT_V(6); PG8_BAR; PG8_MMA(1, 1, At, B1); PG8_BAR;
      PG8_LDB(B0, 1, 0); PG8_SCHED; PG8_LDA(At, 1, 0); PG8_STAGE(PG8_SA(0, 1), a2 + hstep, voffA);
      PG8_WAIT_L(8); PG8_BAR; PG8_WAIT_L(0); PG8_MMA(0, 0, At, B0); PG8_BAR; PG8_SCHED;
      PG8_LDB(B1, 1, 1); PG8_STAGE(PG8_SB(1, 0), b3, voffB);
      PG8_BAR; PG8_WAIT_L(0); PG8_MMA(0, 1, At, B1); PG8_BAR;
      PG8_LDA(At, 1, 1); PG8_STAGE(PG8_SA(1, 0), a3, voffA);
      PG8_BAR; PG8_WAIT_L(0); PG8_MMA(1, 0, At, B0); PG8_BAR; PG8_SCHED;
      PG8_STAGE(PG8_SB(1, 1), b3 + hstep, voffB);
      PG8_WAIT_V(6); PG8_BAR; PG8_MMA(1, 1, At, B1); PG8_BAR;
    }
    E(acc, cur, wr, wc, fr, fq);
    if (!has_next) break;
#pragma unroll
    for (int a = 0; a < 2; ++a)
#pragma unroll
      for (int b = 0; b < 2; ++b)
#pragma unroll
        for (int m = 0; m < 4; ++m)
#pragma unroll
          for (int n = 0; n < 2; ++n) acc[a][b][m][n] = (f32x4){0.f, 0.f, 0.f, 0.f};
    cur = nxt; cA = nA; cB = nB; ++ui;
  }
  PG8_WAIT_V(0);
  if (wr == 0) PG8_BAR;
  PG8_BAR;
#undef PG8_SA
#undef PG8_SB
#undef PG8_STAGE
#undef PG8_LDA
#undef PG8_LDB
#undef PG8_MMA
#undef PG8_WAIT_V
#undef PG8_WAIT_L
#undef PG8_BAR
#undef PG8_SCHED
}
}

enum { EPI_RW = 0, EPI_HG = 1, EPI_OUT = 2 };
constexpr int RW_COL0 = HGP - 128;
template <int EPI>
struct Epi {
  u16* RA; float* out; const float* hlb; float* sumsq;
  __device__ __forceinline__ void operator()(const f32x4 (&acc)[2][2][4][2], const pg8::Unit& u, int wr, int wc, int fr, int fq) const {
#pragma unroll
    for (int ai = 0; ai < 2; ++ai)
#pragma unroll
      for (int m = 0; m < 4; ++m) {
        const int row = u.pm * 256 + ai * 128 + wr * 64 + m * 16 + fr;
        if (EPI == EPI_RW) {
          if (row < M) {
            float* sh = nullptr;
            if (row == TP - 1) sh = out + OUT4;
            else if (row == 2 * TP - 1) sh = out + OUT4 + RWP;
            else if (row >= MP && ((row - MP) & 63) == 63) sh = out + OUT7 + (long)((row - MP) >> 6) * RWP;
#pragma unroll
            for (int bj = 0; bj < 2; ++bj)
#pragma unroll
              for (int n = 0; n < 2; ++n) {
                const int nl = u.pn * 256 + bj * 128 + wc * 32 + n * 16 + fq * 4 - 128;
                if (nl >= 0) {
                  f32x4 a = acc[ai][bj][m][n];
                  uint2 o;
                  o.x = pack2(a[0], a[1]); o.y = pack2(a[2], a[3]);
                  *(uint2*)(RA + (long)row * RWP + nl) = o;
                  if (sh) { float4 f = {a[0], a[1], a[2], a[3]}; *(float4*)(sh + nl) = f; }
                }
              }
          }
        } else if (EPI == EPI_HG) {
          if (row < M) {
            const int grp = u.pn >> 2;
#pragma unroll
            for (int bj = 0; bj < 2; ++bj)
#pragma unroll
              for (int n = 0; n < 2; ++n) {
                const int nn = u.pn * 256 + bj * 128 + wc * 32 + n * 16 + fq * 4;
                const int c = nn & 1023;
                f32x4 a = acc[ai][bj][m][n];
                float r[4];
                if (grp == 0 || grp == 3) {
#pragma unroll
                  for (int e = 0; e < 4; ++e) r[e] = a[e] * sigmoidf_(a[e]);
                } else if (grp == 1) {
                  {
                    const float4 om = *(const float4*)(hlb + c);
                    r[0] = om.x * sigmoidf_(-a[0]); r[1] = om.y * sigmoidf_(-a[1]);
                    r[2] = om.z * sigmoidf_(-a[2]); r[3] = om.w * sigmoidf_(-a[3]);
                  }
                } else {
#pragma unroll
                  for (int e = 0; e < 4; ++e) r[e] = a[e];
                }
                uint2 o;
                o.x = pack2(r[0], r[1]); o.y = pack2(r[2], r[3]);
                *(uint2*)(RA + (long)row * LDH + nn) = o;
              }
          }
        } else {
          long orow = -1;
          if (row < MP) {
            int b = row / TP, t = row - b * TP;
            if (t >= NMETA) orow = (long)b * SEQ + (t - NMETA);
          } else if (row < M) {
            orow = (long)NB * SEQ + (row - MP);
          }
          float ss = 0.f;
#pragma unroll
          for (int bj = 0; bj < 2; ++bj)
#pragma unroll
            for (int n = 0; n < 2; ++n) {
              const int nn = u.pn * 256 + bj * 128 + wc * 32 + n * 16 + fq * 4;
              f32x4 a = acc[ai][bj][m][n];
              ss += a[0] * a[0] + a[1] * a[1] + a[2] * a[2] + a[3] * a[3];
              if (orow >= 0) { uint2 o; o.x = pack2(a[0], a[1]); o.y = pack2(a[2], a[3]); *(uint2*)(RA + orow * D + nn) = o; }
            }
          ss += __shfl_xor(ss, 16);
          ss += __shfl_xor(ss, 32);
          if (fq == 0 && orow >= 0) atomicAdd(sumsq + row, ss);
        }
      }
  }
};

template <int EPI>
__device__ __forceinline__ void run_gemm(const Params& p, const u16* A, const u16* Bt, int N, char* smem) {
  pg8::Gemm g;
  g.A = A; g.Bt = Bt; g.M = MPAD; g.N = N; g.K = D; g.ld = LDU;
  pg8::StaticOrder S;
  S.init(MPAD, N, (int)gridDim.x, (int)blockIdx.x);
  Epi<EPI> E;
  E.RA = p.RA; E.out = p.out; E.hlb = p.omlb; E.sumsq = p.sumsq;
  pg8::gemm_phase<Epi<EPI>>((PG8_LAS unsigned char*)smem, g, S, E);
}

__device__ void phase_rwprep(const Params& p, char* smem) {
  u16* twd = (u16*)smem;
  u16* xad = (u16*)(smem + 2304);
  u16* wl = (u16*)(smem + 8192);
  u16* al = wl + 16384;
  const int tid = threadIdx.x, lane = tid & 63, wave = tid >> 6;
  const int fr = lane & 15, fq = lane >> 4;
  const int th = tid >> 8, cg = tid & 255, c0 = cg * 4;
  const u16* raw = p.RA;
  const float4 mu_r = *(const float4*)(p.mu + c0), mu_k = *(const float4*)(p.mu + 1024 + c0),
               mu_v = *(const float4*)(p.mu + 2048 + c0), mu_g = *(const float4*)(p.mu + 3072 + c0);
  const float4 w0 = *(const float4*)(p.w0 + c0), a0 = *(const float4*)(p.a0 + c0), kkc = *(const float4*)(p.k_k + c0),
               kac = *(const float4*)(p.k_a + c0), rkc = *(const float4*)(p.r_k + c0);
  for (int tile = blockIdx.x; tile < M / 16; tile += gridDim.x) {
    const int row0 = tile * 16;
    int seq_start;
    const float* shiftp = nullptr;
    if (row0 < MP) { int b = row0 / TP; seq_start = b * TP; }
    else { int sb = (row0 - MP) >> 6; seq_start = MP + sb * 64; shiftp = p.state_shift + (long)sb * RWP; }
    const bool first = (row0 == seq_start);
#pragma unroll
    for (int i = 0; i < 4; ++i) {
      int e = tid + 512 * i;
      int t = e >> 7, c = e & 127, col = 4096 + c;
      float pc = bf2f(raw[(long)(row0 + t) * RWP + col]);
      float pp;
      if (t == 0 && first) pp = shiftp ? shiftp[col] : 0.f;
      else pp = bf2f(raw[(long)(row0 + t - 1) * RWP + col]);
      float xm = pc + (pp - pc) * p.mu[col];
      if (c < 64) twd[t * 72 + c] = f2bf(tanhf_(xm));
      else xad[t * 72 + (c - 64)] = f2bf(xm);
    }
    __syncthreads();
    {
      bf16x8_t aw[2], aa[2];
#pragma unroll
      for (int ks = 0; ks < 2; ++ks) {
        aw[ks] = *(const bf16x8_t*)(twd + fr * 72 + ks * 32 + fq * 8);
        aa[ks] = *(const bf16x8_t*)(xad + fr * 72 + ks * 32 + fq * 8);
      }
#pragma unroll
      for (int nt = 0; nt < 8; ++nt) {
        const int n0 = wave * 128 + nt * 16;
        f32x4 accw = {0.f, 0.f, 0.f, 0.f}, acca = {0.f, 0.f, 0.f, 0.f};
#pragma unroll
        for (int ks = 0; ks < 2; ++ks) {
          bf16x8_t bw = *(const bf16x8_t*)(p.w2T + (n0 + fr) * 64 + ks * 32 + fq * 8);
          bf16x8_t ba = *(const bf16x8_t*)(p.a2T + (n0 + fr) * 64 + ks * 32 + fq * 8);
          accw = __builtin_amdgcn_mfma_f32_16x16x32_bf16(aw[ks], bw, accw, 0, 0, 0);
          acca = __builtin_amdgcn_mfma_f32_16x16x32_bf16(aa[ks], ba, acca, 0, 0, 0);
        }
#pragma unroll
        for (int e = 0; e < 4; ++e) {
          wl[(fq * 4 + e) * 1024 + n0 + fr] = f2bf(accw[e]);
          al[(fq * 4 + e) * 1024 + n0 + fr] = f2bf(acca[e]);
        }
      }
    }
    __syncthreads();
    {
      const int t0 = th * 8;
      float pr[4], pk[4], pv[4], pg[4];
      float Wl[4] = {1.f, 1.f, 1.f, 1.f};
      if (t0 == 0 && first) {
        if (shiftp) {
          float4 a = *(const float4*)(shiftp + c0), b = *(const float4*)(shiftp + 1024 + c0),
                 c = *(const float4*)(shiftp + 2048 + c0), d = *(const float4*)(shiftp + 3072 + c0);
          pr[0] = a.x; pr[1] = a.y; pr[2] = a.z; pr[3] = a.w; pk[0] = b.x; pk[1] = b.y; pk[2] = b.z; pk[3] = b.w;
          pv[0] = c.x; pv[1] = c.y; pv[2] = c.z; pv[3] = c.w; pg[0] = d.x; pg[1] = d.y; pg[2] = d.z; pg[3] = d.w;
        } else {
#pragma unroll
          for (int j = 0; j < 4; ++j) pr[j] = pk[j] = pv[j] = pg[j] = 0.f;
        }
      } else {
        const u16* rp = raw + (long)(row0 + t0 - 1) * RWP + c0;
        uint2 a = *(const uint2*)(rp), b = *(const uint2*)(rp + 1024), c = *(const uint2*)(rp + 2048), d = *(const uint2*)(rp + 3072);
        pr[0] = bflo(a.x); pr[1] = bfhi(a.x); pr[2] = bflo(a.y); pr[3] = bfhi(a.y);
        pk[0] = bflo(b.x); pk[1] = bfhi(b.x); pk[2] = bflo(b.y); pk[3] = bfhi(b.y);
        pv[0] = bflo(c.x); pv[1] = bfhi(c.x); pv[2] = bflo(c.y); pv[3] = bfhi(c.y);
        pg[0] = bflo(d.x); pg[1] = bfhi(d.x); pg[2] = bflo(d.y); pg[3] = bfhi(d.y);
      }
      const float mur[4] = {mu_r.x, mu_r.y, mu_r.z, mu_r.w}, muk[4] = {mu_k.x, mu_k.y, mu_k.z, mu_k.w},
                  muv[4] = {mu_v.x, mu_v.y, mu_v.z, mu_v.w}, mug[4] = {mu_g.x, mu_g.y, mu_g.z, mu_g.w};
      const float w0a[4] = {w0.x, w0.y, w0.z, w0.w}, a0a[4] = {a0.x, a0.y, a0.z, a0.w}, kka[4] = {kkc.x, kkc.y, kkc.z, kkc.w},
                  kaa[4] = {kac.x, kac.y, kac.z, kac.w}, rka[4] = {rkc.x, rkc.y, rkc.z, rkc.w};
#pragma unroll
      for (int tt = 0; tt < 8; ++tt) {
        const int t = t0 + tt;
        const u16* rp = raw + (long)(row0 + t) * RWP + c0;
        uint2 ua = *(const uint2*)(rp), ub = *(const uint2*)(rp + 1024), uc = *(const uint2*)(rp + 2048), ud = *(const uint2*)(rp + 3072);
        uint2 ul = *(const uint2*)(wl + t * 1024 + c0), ula = *(const uint2*)(al + t * 1024 + c0);
        const float cr[4] = {bflo(ua.x), bfhi(ua.x), bflo(ua.y), bfhi(ua.y)}, ck[4] = {bflo(ub.x), bfhi(ub.x), bflo(ub.y), bfhi(ub.y)},
                    cv[4] = {bflo(uc.x), bfhi(uc.x), bflo(uc.y), bfhi(uc.y)}, cgt[4] = {bflo(ud.x), bfhi(ud.x), bflo(ud.y), bfhi(ud.y)},
                    lw[4] = {bflo(ul.x), bfhi(ul.x), bflo(ul.y), bfhi(ul.y)}, la[4] = {bflo(ula.x), bfhi(ula.x), bflo(ula.y), bfhi(ula.y)};
        float xr[4], xk[4], xv[4], gs[4], ee[4], aa_[4], kkr[4], kp[4];
        float ss = 0.f, bon = 0.f;
#pragma unroll
        for (int j = 0; j < 4; ++j) {
          xr[j] = cr[j] + (pr[j] - cr[j]) * mur[j];
          xk[j] = ck[j] + (pk[j] - ck[j]) * muk[j];
          xv[j] = cv[j] + (pv[j] - cv[j]) * muv[j];
          float xg = cgt[j] + (pg[j] - cgt[j]) * mug[j];
          pr[j] = cr[j]; pk[j] = ck[j]; pv[j] = cv[j]; pg[j] = cgt[j];
          ee[j] = 1.0f - __expf(-0.60653066f * sigmoidf_(w0a[j] + lw[j]));
          aa_[j] = sigmoidf_(a0a[j] + la[j]);
          kkr[j] = xk[j] * kka[j];
          ss += kkr[j] * kkr[j];
          kp[j] = xk[j] * (1.0f + (aa_[j] - 1.0f) * kaa[j]);
          bon += xr[j] * kp[j] * rka[j];
          gs[j] = xg * sigmoidf_(xg);
        }
        ss = allreduce16(ss);
        bon = allreduce16(bon);
        const float inv = rsqrtf(fmaxf(ss, 1e-24f));
        if (fr == 0) p.bonus[(long)(row0 + t) * 16 + (cg >> 4)] = bon;
        float kk[4], bb[4], rs_[4], ks_[4];
#pragma unroll
        for (int j = 0; j < 4; ++j) {
          const float Wp = Wl[j];
          Wl[j] *= (1.0f - ee[j]);
          const float iw = frcp(Wl[j]);
          const float kkn = kkr[j] * inv;
          kk[j] = kkn * Wp;
          bb[j] = kkn * aa_[j] * iw;
          rs_[j] = xr[j] * Wl[j];
          ks_[j] = kp[j] * iw;
        }
        const long po = (long)(row0 + t) * LDP + c0;
        uint2 o;
        o.x = pack2(rs_[0], rs_[1]); o.y = pack2(rs_[2], rs_[3]); *(uint2*)(p.pl_r + po) = o;
        o.x = pack2(ks_[0], ks_[1]); o.y = pack2(ks_[2], ks_[3]); *(uint2*)(p.pl_k + po) = o;
        o.x = pack2(xv[0], xv[1]); o.y = pack2(xv[2], xv[3]); *(uint2*)(p.pl_v + po) = o;
        o.x = pack2(kk[0], kk[1]); o.y = pack2(kk[2], kk[3]); *(uint2*)(p.pl_kk + po) = o;
        o.x = pack2(bb[0], bb[1]); o.y = pack2(bb[2], bb[3]); *(uint2*)(p.pl_b + po) = o;
        o.x = pack2(gs[0], gs[1]); o.y = pack2(gs[2], gs[3]); *(uint2*)(p.pl_g + po) = o;
      }
      {
        float4 gw = {Wl[0], Wl[1], Wl[2], Wl[3]};
        *(float4*)(p.Gp + (long)((row0 + t0) >> 3) * 1024 + c0) = gw;
      }
    }
    __syncthreads();
  }
}

__device__ void rwkv_unit(const Params& p, float* sm, int row0, int len, int h, int q, const float* S0,
                          float* Sout) {
  const int tid = threadIdx.x, wave = tid >> 6, lane = tid & 63;
  float* buf = sm;
  float* vT = sm + 16384;
  float* ybuf = sm + 17408;
  float* wend = sm + 18432;
  float* dummyb = sm + 18560;
  const int ntiles = (len + 31) >> 5;
  if (wave < 4) {
    const int rA = wave * 4 + (lane >> 4);
    const int c4 = (lane & 15) * 4;
    f32x2 A01 = {0.f, 0.f}, A23 = {0.f, 0.f};
    if (S0) {
      float4 sa_ = *(const float4*)(S0 + (q * 16 + rA) * 64 + c4);
      A01 = (f32x2){sa_.x, sa_.y}; A23 = (f32x2){sa_.z, sa_.w};
    }
    __syncthreads();
    const int l15 = lane & 15;
    const bool odd1 = (lane & 1) != 0, odd2 = (lane & 2) != 0;
    for (int i = 0; i < ntiles; ++i) {
      const int steps = min(32, len - i * 32);
      const float* bp = buf + (i & 1) * 8192 + c4;
      const float* vpA = vT + (i & 1) * 512 + rA * 32;
      float* yw = (l15 < 4) ? (ybuf + (i & 1) * 512 + (lane & 3) * 16 + rA) : (dummyb + lane);
      f32x4 r4 = *(const f32x4*)(bp), k4 = *(const f32x4*)(bp + 64), kk4 = *(const f32x4*)(bp + 128),
            b4 = *(const f32x4*)(bp + 192);
      f32x4 vA4 = *(const f32x4*)(vpA), nvA4 = vA4;
      float yp[4] = {0.f, 0.f, 0.f, 0.f};
#pragma unroll 1
      for (int s4 = 0; s4 < steps; s4 += 4) {
#pragma unroll
        for (int j4 = 0; j4 < 4; ++j4) {
          const int s = s4 + j4;
          const float* sp = bp + (s + 1) * 256;
          f32x4 nr4 = *(const f32x4*)(sp), nk4 = *(const f32x4*)(sp + 64), nkk4 = *(const f32x4*)(sp + 128),
                nb4 = *(const f32x4*)(sp + 192);
          if (j4 == 0) nvA4 = *(const f32x4*)(vpA + ((s + 4) & 31));
          const f32x2 kk01 = {kk4[0], kk4[1]}, kk23 = {kk4[2], kk4[3]}, k01 = {k4[0], k4[1]}, k23 = {k4[2], k4[3]},
                      b01 = {b4[0], b4[1]}, b23 = {b4[2], b4[3]}, r01 = {r4[0], r4[1]}, r23 = {r4[2], r4[3]};
          f32x2 tA = A01 * kk01;
          tA = __builtin_elementwise_fma(A23, kk23, tA);
          const f32x2 vA2 = {vA4[j4], vA4[j4]};
          A01 = __builtin_elementwise_fma(vA2, k01, A01);
          A23 = __builtin_elementwise_fma(vA2, k23, A23);
          const float saA = allreduce16(tA[0] + tA[1]);
          const f32x2 sA2 = {saA, saA};
          A01 = __builtin_elementwise_fma(-sA2, b01, A01);
          A23 = __builtin_elementwise_fma(-sA2, b23, A23);
          f32x2 uA = A01 * r01;
          uA = __builtin_elementwise_fma(A23, r23, uA);
          yp[j4] = uA[0] + uA[1];
          if (j4 == 3) {
            float a = odd1 ? yp[1] : yp[0], bs = odd1 ? yp[0] : yp[1];
            float c = odd1 ? yp[3] : yp[2], ds = odd1 ? yp[2] : yp[3];
            a += __int_as_float(__builtin_amdgcn_update_dpp(0, __float_as_int(bs), 0xB1, 0xF, 0xF, true));
            c += __int_as_float(__builtin_amdgcn_update_dpp(0, __float_as_int(ds), 0xB1, 0xF, 0xF, true));
            float e = odd2 ? c : a, fs = odd2 ? a : c;
            e += __int_as_float(__builtin_amdgcn_update_dpp(0, __float_as_int(fs), 0x4E, 0xF, 0xF, true));
            e = dpp_add<0x124>(e);
            e = dpp_add<0x128>(e);
            yw[s4 * 16] = e;
          }
          r4 = nr4; k4 = nk4; kk4 = nkk4; b4 = nb4;
          if (j4 == 3) vA4 = nvA4;
        }
      }
      {
        f32x4 we = *(const f32x4*)(wend + (i & 1) * 64 + c4);
        A01 *= (f32x2){we[0], we[1]}; A23 *= (f32x2){we[2], we[3]};
      }
      __syncthreads();
    }
    float4 so = {A01[0], A01[1], A23[0], A23[1]};
    *(float4*)(Sout + (q * 16 + rA) * 64 + c4) = so;
  } else {
    const int ht = tid - 256;
    const int c = ht & 63, role = ht >> 6;
    const int vstep = ht >> 1, vch = ht & 1;
    const int urole = __builtin_amdgcn_readfirstlane(role);
    const u16* pl = (urole == 0) ? p.pl_r : (urole == 1) ? p.pl_k : (urole == 2) ? p.pl_kk : p.pl_b;
    u16 pp[32];
    float G[4] = {1.f, 1.f, 1.f, 1.f};
    uint4 rv = {0u, 0u, 0u, 0u};
    auto gload = [&](int i) {
      if (i >= ntiles) return;
      const u16* base = pl + (long)(row0 + i * 32) * LDP + h * 64;
#pragma unroll
      for (int t = 0; t < 32; ++t) pp[t] = base[t * LDP + c];
      const float* gbase = p.Gp + (long)((row0 + i * 32) >> 3) * 1024 + h * 64;
#pragma unroll
      for (int g = 0; g < 4; ++g) G[g] = gbase[g * 1024 + c];
      if (ht < 64) rv = *(const uint4*)(p.pl_v + (long)(row0 + i * 32 + vstep) * LDP + h * 64 + q * 16 + vch * 8);
    };
    auto lwrite = [&](int i) {
      float* bp = buf + (i & 1) * 8192 + role * 64 + c;
      const int ngroups = min(32, len - i * 32) >> 3;
      float Wg[4];
      Wg[0] = 1.0f; Wg[1] = G[0]; Wg[2] = Wg[1] * G[1]; Wg[3] = Wg[2] * G[2];
      const float Wall = Wg[3] * G[3];
      float m[4];
#pragma unroll
      for (int g = 0; g < 4; ++g) m[g] = (role == 0 || role == 2) ? Wg[g] : frcp(Wg[g]);
#pragma unroll
      for (int t = 0; t < 32; ++t) bp[t * 256] = bf2f(pp[t]) * m[t >> 3];
      if (role == 0) wend[(i & 1) * 64 + c] = (ngroups >= 4) ? Wall : Wg[ngroups & 3];
      if (ht < 64) {
        float* vt = vT + (i & 1) * 512 + (vch * 8) * 32 + vstep;
        vt[0] = bflo(rv.x); vt[32] = bfhi(rv.x); vt[64] = bflo(rv.y); vt[96] = bfhi(rv.y);
        vt[128] = bflo(rv.z); vt[160] = bfhi(rv.z); vt[192] = bflo(rv.w); vt[224] = bfhi(rv.w);
      }
    };
    auto yflush = [&](int i) {
      if (ht < 64 && (i * 32 + vstep) < len) {
        const float* yb = ybuf + (i & 1) * 512 + vstep * 16 + vch * 8;
        float4 a = *(const float4*)yb, b = *(const float4*)(yb + 4);
        uint4 o;
        o.x = pack2(a.x, a.y); o.y = pack2(a.z, a.w); o.z = pack2(b.x, b.y); o.w = pack2(b.z, b.w);
        *(uint4*)(p.U + (long)(row0 + i * 32 + vstep) * LDU + 1024 + h * 64 + q * 16 + vch * 8) = o;
      }
    };
    gload(0);
    lwrite(0);
    gload(1);
    __syncthreads();
    for (int i = 0; i < ntiles; ++i) {
      if (i + 1 < ntiles) lwrite(i + 1);
      gload(i + 2);
      if (i >= 1) yflush(i - 1);
      __syncthreads();
    }
    yflush(ntiles - 1);
  }
  __syncthreads();
}

__device__ void hgrn_unit(const Params& p, float* sm, int row0, int len, int h, int vs, const float* S0,
                          float* Sout) {
  const int tid = threadIdx.x, wave = tid >> 6, lane = tid & 63;
  float* buf = sm;
  float* vT = sm + 16384;
  float* opart = sm + 17408;
  const u16* P = p.RA;
  const int ntiles = (len + 31) >> 5;
  if (wave < 4) {
    const int kg = lane & 3, vcol = lane >> 2;
    const int krow0 = wave * 32 + kg * 8;
    f32x2 S[4] = {{0.f, 0.f}, {0.f, 0.f}, {0.f, 0.f}, {0.f, 0.f}};
    if (S0) {
      const float* s0 = S0 + (long)krow0 * 128 + vs * 16 + vcol;
#pragma unroll
      for (int j = 0; j < 4; ++j) S[j] = (f32x2){s0[(2 * j) * 128], s0[(2 * j + 1) * 128]};
    }
    __syncthreads();
    const bool odd1 = (lane & 1) != 0, odd2 = (lane & 2) != 0;
    for (int i = 0; i < ntiles; ++i) {
      const int steps = min(32, len - i * 32);
      const float* bp = buf + (i & 1) * 8192 + krow0;
      const float* vp = vT + (i & 1) * 512 + vcol * 32;
      float* ob = opart + (i & 1) * 2048 + kg * 64 + wave * 16 + vcol;
      f32x4 qa = *(const f32x4*)(bp), qb = *(const f32x4*)(bp + 4), ka = *(const f32x4*)(bp + 128), kb = *(const f32x4*)(bp + 132);
      f32x4 v4 = *(const f32x4*)(vp), nv4 = v4;
      float op[4] = {0.f, 0.f, 0.f, 0.f};
#pragma unroll 1
      for (int s4 = 0; s4 < steps; s4 += 4) {
#pragma unroll
        for (int j4 = 0; j4 < 4; ++j4) {
          const int s = s4 + j4;
          const float* sp = bp + (s + 1) * 256;
          f32x4 nqa = *(const f32x4*)(sp), nqb = *(const f32x4*)(sp + 4), nka = *(const f32x4*)(sp + 128), nkb = *(const f32x4*)(sp + 132);
          if (j4 == 0) nv4 = *(const f32x4*)(vp + ((s + 4) & 31));
          const f32x2 vv2 = {v4[j4], v4[j4]};
          S[0] = __builtin_elementwise_fma((f32x2){ka[0], ka[1]}, vv2 - S[0], S[0]);
          S[1] = __builtin_elementwise_fma((f32x2){ka[2], ka[3]}, vv2 - S[1], S[1]);
          S[2] = __builtin_elementwise_fma((f32x2){kb[0], kb[1]}, vv2 - S[2], S[2]);
          S[3] = __builtin_elementwise_fma((f32x2){kb[2], kb[3]}, vv2 - S[3], S[3]);
          f32x2 u = S[0] * (f32x2){qa[0], qa[1]};
          u = __builtin_elementwise_fma(S[1], (f32x2){qa[2], qa[3]}, u);
          u = __builtin_elementwise_fma(S[2], (f32x2){qb[0], qb[1]}, u);
          u = __builtin_elementwise_fma(S[3], (f32x2){qb[2], qb[3]}, u);
          op[j4] = u[0] + u[1];
          if (j4 == 3) {
            float a = odd1 ? op[1] : op[0], bs = odd1 ? op[0] : op[1];
            float c = odd1 ? op[3] : op[2], ds = odd1 ? op[2] : op[3];
            a += __int_as_float(__builtin_amdgcn_update_dpp(0, __float_as_int(bs), 0xB1, 0xF, 0xF, true));
            c += __int_as_float(__builtin_amdgcn_update_dpp(0, __float_as_int(ds), 0xB1, 0xF, 0xF, true));
            float e = odd2 ? c : a, fs = odd2 ? a : c;
            e += __int_as_float(__builtin_amdgcn_update_dpp(0, __float_as_int(fs), 0x4E, 0xF, 0xF, true));
            ob[s4 * 64] = e;
          }
          qa = nqa; qb = nqb; ka = nka; kb = nkb;
          if (j4 == 3) v4 = nv4;
        }
      }
      __syncthreads();
    }
    {
      float* so = Sout + (long)krow0 * 128 + vs * 16 + vcol;
#pragma unroll
      for (int j = 0; j < 4; ++j) { so[(2 * j) * 128] = S[j][0]; so[(2 * j + 1) * 128] = S[j][1]; }
    }
  } else {
    const int ht = tid - 256;
    const int vstep = ht >> 1, vch = ht & 1;
    uint4 rq[2], rk[2], rv = {0u, 0u, 0u, 0u};
    auto gload = [&](int i) {
      if (i >= ntiles) return;
      const u16* base = P + (long)(row0 + i * 32) * LDH + h * 128;
#pragma unroll
      for (int j = 0; j < 2; ++j) {
        const int cid = ht + 256 * j, step = cid >> 4, ch = cid & 15;
        const u16* q_ = base + step * LDH + ch * 8;
        rq[j] = *(const uint4*)(q_);
        rk[j] = *(const uint4*)(q_ + 1024);
      }
      if (ht < 64) rv = *(const uint4*)(base + vstep * LDH + 2048 + vs * 16 + vch * 8);
    };
    auto lwrite = [&](int i) {
      float* bp = buf + (i & 1) * 8192;
#pragma unroll
      for (int j = 0; j < 2; ++j) {
        const int cid = ht + 256 * j, step = cid >> 4, ch = cid & 15;
        unpack8_store(rq[j], bp + step * 256 + ch * 8);
        unpack8_store(rk[j], bp + step * 256 + 128 + ch * 8);
      }
      if (ht < 64) {
        float* vt = vT + (i & 1) * 512 + (vch * 8) * 32 + vstep;
        vt[0] = bflo(rv.x); vt[32] = bfhi(rv.x); vt[64] = bflo(rv.y); vt[96] = bfhi(rv.y);
        vt[128] = bflo(rv.z); vt[160] = bfhi(rv.z); vt[192] = bflo(rv.w); vt[224] = bfhi(rv.w);
      }
    };
    auto oflush = [&](int i) {
#pragma unroll
      for (int j = 0; j < 2; ++j) {
        const int oid = ht + 256 * j, st = oid >> 4, vc = oid & 15;
        if (i * 32 + st < len) {
          const float* op = opart + (i & 1) * 2048 + st * 64 + vc;
          float o = (op[0] + op[16]) + (op[32] + op[48]);
          p.U[(long)(row0 + i * 32 + st) * LDU + h * 128 + vs * 16 + vc] = f2bf(o);
        }
      }
    };
    gload(0);
    lwrite(0);
    gload(1);
    __syncthreads();
    for (int i = 0; i < ntiles; ++i) {
      if (i + 1 < ntiles) lwrite(i + 1);
      gload(i + 2);
      if (i >= 1) oflush(i - 1);
      __syncthreads();
    }
    oflush(ntiles - 1);
  }
  __syncthreads();
}

__device__ void phase_scan(const Params& p, char* smem) {
  float* sm = (float*)smem;
  volatile int* s_nextp = (volatile int*)(smem + 131008);
  for (int id = blockIdx.x; id < 256; id += gridDim.x) {
    if (id < 128) {
      int q = id >> 5, b = (id >> 4) & 1, h = id & 15;
      rwkv_unit(p, sm, b * TP, TP, h, q, nullptr, p.out + OUT3 + (long)(b * 16 + h) * 4096);
    } else {
      int j = id - 128;
      int vs = j >> 4, b = (j >> 3) & 1, h = j & 7;
      hgrn_unit(p, sm, b * TP, TP, h, vs, nullptr, p.out + OUT2 + (long)(b * 8 + h) * 16384);
    }
  }
  if (threadIdx.x == 0) *s_nextp = atomicAdd(p.queue, 1);
  __syncthreads();
  int jn = *s_nextp;
  __syncthreads();
  for (;;) {
    const int j0 = jn;
    if (j0 >= 4096) break;
    if (threadIdx.x == 0) *s_nextp = atomicAdd(p.queue, 1);
    if (j0 < 2048) {
      int j = j0;
      int b = j >> 6, h = (j >> 2) & 15, q = j & 3;
      rwkv_unit(p, sm, MP + b * 64, 64, h, q, p.state_rwkv + (long)(b * 16 + h) * 4096,
                p.out + OUT6 + (long)(b * 16 + h) * 4096);
    } else {
      int j = j0 - 2048;
      int b = j >> 6, h = (j >> 3) & 7, vs = j & 7;
      hgrn_unit(p, sm, MP + b * 64, 64, h, vs, p.state_hgrn + (long)(b * 8 + h) * 16384,
                p.out + OUT5 + (long)(b * 8 + h) * 16384);
    }
    jn = *s_nextp;
    __syncthreads();
  }
}

__device__ __forceinline__ void unpack16(const uint4& a, const uint4& b, float* f) {
  f[0] = bflo(a.x); f[1] = bfhi(a.x); f[2] = bflo(a.y); f[3] = bfhi(a.y); f[4] = bflo(a.z); f[5] = bfhi(a.z); f[6] = bflo(a.w); f[7] = bfhi(a.w);
  f[8] = bflo(b.x); f[9] = bfhi(b.x); f[10] = bflo(b.y); f[11] = bfhi(b.y); f[12] = bflo(b.z); f[13] = bfhi(b.z); f[14] = bflo(b.w); f[15] = bfhi(b.w);
}
__device__ __forceinline__ void pack16(const float* f, uint4& a, uint4& b) {
  a.x = pack2(f[0], f[1]); a.y = pack2(f[2], f[3]); a.z = pack2(f[4], f[5]); a.w = pack2(f[6], f[7]);
  b.x = pack2(f[8], f[9]); b.y = pack2(f[10], f[11]); b.z = pack2(f[12], f[13]); b.w = pack2(f[14], f[15]);
}
__device__ void phase_post(const Params& p) {
  const int tid = threadIdx.x, wave = tid >> 6, lane = tid & 63;
  const int c0 = lane * 16;
  float hgn[16], lnw[16], lnb[16];
#pragma unroll
  for (int j = 0; j < 16; ++j) { hgn[j] = p.hg_norm[c0 + j]; lnw[j] = p.ln_w[c0 + j]; lnb[j] = p.ln_b[c0 + j]; }
  for (int row = blockIdx.x * 8 + wave; row < M; row += gridDim.x * 8) {
    u16* mrow = p.U + (long)row * LDU;
    {
      const uint4* mp = (const uint4*)(mrow + c0);
      const uint4* gp = (const uint4*)(p.RA + (long)row * LDH + 3072 + c0);
      uint4 m0 = mp[0], m1 = mp[1], g0 = gp[0], g1 = gp[1];
      float o[16], g[16];
      unpack16(m0, m1, o);
      unpack16(g0, g1, g);
      float ss = 0.f;
#pragma unroll
      for (int j = 0; j < 16; ++j) ss += o[j] * o[j];
      ss = dpp_add<0xB1>(ss); ss = dpp_add<0x4E>(ss); ss = dpp_add<0x141>(ss);
      const float rs = rsqrtf(ss * (1.0f / 128.0f) + 1e-6f);
#pragma unroll
      for (int j = 0; j < 16; ++j) o[j] = o[j] * rs * hgn[j] * g[j];
      pack16(o, m0, m1);
      ((uint4*)(mrow + c0))[0] = m0;
      ((uint4*)(mrow + c0))[1] = m1;
    }
    {
      const uint4* yp = (const uint4*)(mrow + 1024 + c0);
      const uint4* vp = (const uint4*)(p.pl_v + (long)row * LDP + c0);
      const uint4* gp = (const uint4*)(p.pl_g + (long)row * LDP + c0);
      uint4 y0 = yp[0], y1 = yp[1], v0 = vp[0], v1 = vp[1], g0 = gp[0], g1 = gp[1];
      const float bon = p.bonus[(long)row * 16 + (lane >> 2)];
      float y[16], v[16], g[16];
      unpack16(y0, y1, y);
      unpack16(v0, v1, v);
      unpack16(g0, g1, g);
      float sm_ = 0.f;
#pragma unroll
      for (int j = 0; j < 16; ++j) sm_ += y[j];
      sm_ = allreduce4(sm_);
      const float mean = sm_ * (1.0f / 64.0f);
      float vs = 0.f;
#pragma unroll
      for (int j = 0; j < 16; ++j) { y[j] -= mean; vs += y[j] * y[j]; }
      vs = allreduce4(vs);
      const float rs = rsqrtf(vs * (1.0f / 64.0f) + 64e-5f);
#pragma unroll
      for (int j = 0; j < 16; ++j) y[j] = (y[j] * rs * lnw[j] + lnb[j] + bon * v[j]) * g[j];
      pack16(y, y0, y1);
      ((uint4*)(mrow + 1024 + c0))[0] = y0;
      ((uint4*)(mrow + 1024 + c0))[1] = y1;
    }
  }
}

__device__ void phase_final(const Params& p) {
  const long n4 = (OUT2) / 4;
  const long stride = (long)gridDim.x * blockDim.x;
#pragma unroll 4
  for (long idx = (long)blockIdx.x * blockDim.x + threadIdx.x; idx < n4; idx += stride) {
    long orow = idx >> 9;
    int c4 = (int)(idx & 511);
    int flat;
    const float* x;
    if (orow < (long)NB * SEQ) {
      int b = (int)(orow >> 14), t = (int)(orow & 16383);
      flat = b * TP + NMETA + t;
      x = p.x_prompt + orow * D;
    } else {
      flat = MP + (int)(orow - (long)NB * SEQ);
      x = p.x_sample + (orow - (long)NB * SEQ) * D;
    }
    float rstd = rsqrtf(p.sumsq[flat] * (1.0f / D) + 1e-6f);
    float4 xv = ((const float4*)x)[c4];
    float4 g = ((const float4*)p.norm_post)[c4];
    uint2 zb = ((const uint2*)p.RA)[idx];
    float4 o;
    o.x = xv.x + bflo(zb.x) * rstd * g.x; o.y = xv.y + bfhi(zb.x) * rstd * g.y;
    o.z = xv.z + bflo(zb.y) * rstd * g.z; o.w = xv.w + bfhi(zb.y) * rstd * g.w;
    ((float4*)p.out)[idx] = o;
  }
}

__device__ __forceinline__ void fast_grid_barrier(unsigned* ctr, unsigned target) {
  __syncthreads();
  if (threadIdx.x == 0) {
    __builtin_amdgcn_fence(__ATOMIC_RELEASE, "agent");
    asm volatile("s_waitcnt vmcnt(0) lgkmcnt(0)" ::: "memory");
    __hip_atomic_fetch_add(ctr, 1u, __ATOMIC_RELAXED, __HIP_MEMORY_SCOPE_AGENT);
    while (__hip_atomic_load(ctr, __ATOMIC_RELAXED, __HIP_MEMORY_SCOPE_AGENT) < target) __builtin_amdgcn_s_sleep(2);
    __builtin_amdgcn_fence(__ATOMIC_ACQUIRE, "agent");
    asm volatile("s_waitcnt vmcnt(0) lgkmcnt(0)" ::: "memory");
  }
  __syncthreads();
}

__global__ void __launch_bounds__(512) hymba_mega(Params p) {
  cg::grid_group grid = cg::this_grid();
  __shared__ __attribute__((aligned(1024))) char smem[SMEM_BYTES];
  phase_prep(p, smem);
  grid.sync();
  unsigned* bar = (unsigned*)(p.queue + 16);
  const unsigned nb = gridDim.x;
  run_gemm<EPI_RW>(p, p.U, p.WinT + (long)RW_COL0 * LDU, RWP + 128, smem);
  fast_grid_barrier(bar, 1u * nb);
  phase_rwprep(p, smem);
  fast_grid_barrier(bar, 2u * nb);
  run_gemm<EPI_HG>(p, p.U, p.WinT, HGP, smem);
  fast_grid_barrier(bar, 3u * nb);
  phase_scan(p, smem);
  fast_grid_barrier(bar, 4u * nb);
  phase_post(p);
  fast_grid_barrier(bar, 5u * nb);
  run_gemm<EPI_OUT>(p, p.U, p.WoutT, D, smem);
  fast_grid_barrier(bar, 6u * nb);
  phase_final(p);
}

extern "C" void kernel_launch(void* const* d_in, const int* in_sizes, int n_in, void* d_out, int out_size,
                              void* d_ws, size_t ws_size, hipStream_t stream) {
  static int grid_blocks = 0;
  if (!grid_blocks) {
    int dev = 0, cus = 0, per_cu = 0;
    (void)hipGetDevice(&dev);
    (void)hipDeviceGetAttribute(&cus, hipDeviceAttributeMultiprocessorCount, dev);
    (void)hipOccupancyMaxActiveBlocksPerMultiprocessor(&per_cu, hymba_mega, 512, 0);
    if (per_cu > 1) per_cu = 1;
    grid_blocks = cus * per_cu;
    grid_blocks -= grid_blocks % 8;
  }
  Params p{};
  const float* const* in = (const float* const*)d_in;
  p.x_prompt = in[0]; p.x_sample = in[1]; p.state_hgrn = in[2]; p.state_rwkv = in[3]; p.state_shift = in[4];
  p.meta = in[5]; p.norm_pre = in[6]; p.w_in = in[7]; p.hlb = in[8]; p.hg_norm = in[9]; p.mu = in[10];
  p.w0 = in[11]; p.w2 = in[12]; p.a0 = in[13]; p.a2 = in[14]; p.k_k = in[15]; p.k_a = in[16]; p.r_k = in[17];
  p.ln_w = in[18]; p.ln_b = in[19]; p.w_out = in[20]; p.norm_post = in[21];
  p.out = (float*)d_out;
  char* ws = (char*)d_ws;
  size_t off = 0;
  p.WinT = (u16*)(ws + off); off += (size_t)PT * LDU * 2;
  p.WoutT = (u16*)(ws + off); off += (size_t)D * LDU * 2;
  p.U = (u16*)(ws + off); off += (size_t)MPAD * LDU * 2;
  p.RA = (u16*)(ws + off); off += (size_t)MPAD * RWP * 2;
  const size_t plane = (size_t)M * LDP * 2;
  p.pl_r = (u16*)(ws + off); off += plane;
  p.pl_k = (u16*)(ws + off); off += plane;
  p.pl_v = (u16*)(ws + off); off += plane;
  p.pl_kk = (u16*)(ws + off); off += plane;
  p.pl_b = (u16*)(ws + off); off += plane;
  p.pl_e = (u16*)(ws + off); off += plane;
  p.pl_g = (u16*)(ws + off); off += plane;
  p.bonus = (float*)(ws + off); off += (size_t)M * 16 * 4;
  p.sumsq = (float*)(ws + off); off += (size_t)M * 4;
  p.queue = (int*)(ws + off); off += 256;
  p.w2T = (u16*)(ws + off); off += 1024 * 64 * 2;
  p.a2T = (u16*)(ws + off); off += 1024 * 64 * 2;
  p.Gp = (float*)(ws + off); off += (size_t)(M / 8) * 1024 * 4;
  p.omlb = (float*)(ws + off); off += 1024 * 4;
  if (off > ws_size) fprintf(stderr, "workspace too small: need %zu have %zu\n", off, ws_size);
  void* args[] = {&p};
  hipError_t e = hipLaunchCooperativeKernel((void*)hymba_mega, dim3(grid_blocks), dim3(512), args, 0, stream);
  if (e != hipSuccess) fprintf(stderr, "coop launch failed: %s (grid %d)\n", hipGetErrorString(e), grid_blocks);
}
```
